# Optimizing an MI355X kernel written in HIP

```python
import math
import jax, jax.numpy as jnp
from jax import lax
import numpy as np

D_MODEL = 1024
BATCH = 4
SEQ = 4096
DEPTH = 2

CHUNK = 64
Q_BLOCK = 128
EPS = 1e-6
MAX_OFFSET = 4096

HG_HEADS = 4
HG_DK = 128
HG_DV = 128
HG_WIDTH = HG_HEADS * HG_DV

MLA_HEADS = 8
MLA_NOPE = 64
MLA_ROPE = 32
MLA_V = 64
MLA_Q_LORA = 384
MLA_KV_LORA = 256
MLA_DQK = MLA_NOPE + MLA_ROPE
MLA_WIDTH = MLA_HEADS * MLA_V
ROPE_BASE = 10000.0

N_EXPERTS = 16
N_GROUPS = 4
EXPERTS_PER_GROUP = N_EXPERTS // N_GROUPS
TOPK_GROUPS = 1
TOP_K = 2
D_EXPERT = 512

IN_SIZES = (HG_HEADS * HG_DK,
            HG_HEADS * HG_DK,
            HG_HEADS * HG_DV,
            HG_WIDTH,
            MLA_Q_LORA,
            MLA_KV_LORA,
            MLA_ROPE,
            2 * D_MODEL)
IN_COLS = int(sum(IN_SIZES))
IN_SPLITS = tuple(int(v) for v in np.cumsum(IN_SIZES)[:-1])

kernel_name = "hybrid_hgrn2_mla_grouped_moe_adaln"


def rmsnorm(x, g):
    xf = x.astype(jnp.float32)
    y = xf * lax.rsqrt(jnp.mean(xf * xf, axis=-1, keepdims=True) + EPS)
    return (y * g.astype(jnp.float32)).astype(x.dtype)


def rotary(x, pos):
    half = x.shape[-1] // 2
    inv = ROPE_BASE ** (-jnp.arange(half, dtype=jnp.float32) / half)
    ang = pos.astype(jnp.float32)[..., None] * inv
    cos = jnp.cos(ang)[:, :, None, :]
    sin = jnp.sin(ang)[:, :, None, :]
    xf = x.astype(jnp.float32)
    x1, x2 = xf[..., :half], xf[..., half:]
    return jnp.concatenate([x1 * cos - x2 * sin, x1 * sin + x2 * cos], -1).astype(x.dtype)


def hgrn2_mix(q, f_logit, v, lb):
    B, S = q.shape[0], q.shape[1]
    nc = S // CHUNK
    lbh = lb.astype(jnp.float32).reshape(HG_HEADS, HG_DK)
    f = lbh + (1.0 - lbh) * jax.nn.sigmoid(f_logit.astype(jnp.float32))
    log_f = jnp.log(f)
    k = 1.0 - f
    qf = jax.nn.silu(q.astype(jnp.float32)) * (HG_DK ** -0.5)
    vf = v.astype(jnp.float32)

    def to_chunks(t):
        return t.reshape(B, nc, CHUNK, HG_HEADS, t.shape[-1]).transpose(1, 0, 3, 2, 4)

    qc, kc, vc, gc = to_chunks(qf), to_chunks(k), to_chunks(vf), to_chunks(log_f)
    causal = jnp.tril(jnp.ones((CHUNK, CHUNK), dtype=bool))[:, :, None]

    def step(state, inp):
        qb, kb, vb, gb = inp
        b = jnp.cumsum(gb, axis=2)
        rel = b[:, :, :, None, :] - b[:, :, None, :, :]
        decay = jnp.exp(jnp.where(causal, rel, -jnp.inf))
        attn = jnp.einsum('bhtd,bhtsd,bhsd->bhts', qb, decay, kb)
        intra = jnp.einsum('bhts,bhsv->bhtv', attn, vb)
        inter = jnp.einsum('bhtd,bhdv->bhtv', qb * jnp.exp(b), state)
        b_last = b[:, :, -1:, :]
        k_dec = kb * jnp.exp(b_last - b)
        new_state = state * jnp.exp(b_last[:, :, 0, :, None]) + jnp.einsum('bhsd,bhsv->bhdv', k_dec, vb)
        return new_state, intra + inter

    state0 = jnp.zeros((B, HG_HEADS, HG_DK, HG_DV), jnp.float32)
    _, out = lax.scan(step, state0, (qc, kc, vc, gc))
    return out.transpose(1, 0, 3, 2, 4).reshape(B, S, HG_HEADS, HG_DV)


def mla_mix(c_q, c_kv, k_rope, pos, q_norm_g, w_q_up, kv_norm_g, w_kv_up):
    B, S = c_q.shape[0], c_q.shape[1]
    q = (rmsnorm(c_q, q_norm_g) @ w_q_up).reshape(B, S, MLA_HEADS, MLA_DQK)
    q = jnp.concatenate([q[..., :MLA_NOPE], rotary(q[..., MLA_NOPE:], pos)], -1)
    kv = (rmsnorm(c_kv, kv_norm_g) @ w_kv_up).reshape(B, S, MLA_HEADS, MLA_NOPE + MLA_V)
    k_nope, v = kv[..., :MLA_NOPE], kv[..., MLA_NOPE:]
    k_pe = rotary(k_rope[:, :, None, :], pos)
    k = jnp.concatenate([k_nope, jnp.broadcast_to(k_pe, (B, S, MLA_HEADS, MLA_ROPE)).astype(k_nope.dtype)], -1)
    scale = MLA_DQK ** -0.5
    nb = S // Q_BLOCK
    qb = q.reshape(B, nb, Q_BLOCK, MLA_HEADS, MLA_DQK).transpose(1, 0, 2, 3, 4)
    key_chunk = jnp.arange(S) // CHUNK

    def block(args):
        qblk, start = args
        q_chunk = (start + jnp.arange(Q_BLOCK)) // CHUNK
        s = jnp.einsum('bqhd,bkhd->bhqk', qblk, k, preferred_element_type=jnp.float32) * scale
        mask = key_chunk[None, :] <= q_chunk[:, None]
        p = jax.nn.softmax(jnp.where(mask, s, -jnp.inf), axis=-1).astype(v.dtype)
        return jnp.einsum('bhqk,bkhd->bqhd', p, v)

    out = lax.map(block, (qb, jnp.arange(nb, dtype=jnp.int32) * Q_BLOCK))
    return out.transpose(1, 0, 2, 3, 4).reshape(B, S, MLA_WIDTH)


def token_mix(h, pos, w_in, lb, hg_norm_g, q_norm_g, w_q_up, kv_norm_g, w_kv_up, w_br_a, w_br_b, w_out):
    B, S, D = h.shape
    proj = h @ w_in
    hq, hf, hi, hgate, cq, ckv, kr, gates = jnp.split(proj, IN_SPLITS, axis=-1)
    o_a = hgrn2_mix(hq.reshape(B, S, HG_HEADS, HG_DK), hf.reshape(B, S, HG_HEADS, HG_DK),
                    hi.reshape(B, S, HG_HEADS, HG_DV), lb)
    o_a = rmsnorm(o_a, hg_norm_g.reshape(HG_HEADS, HG_DV)).reshape(B, S, HG_WIDTH)
    o_a = (o_a * jax.nn.silu(hgate.astype(jnp.float32))).astype(h.dtype)
    y_a = o_a @ w_br_a
    y_b = mla_mix(cq, ckv, kr, pos, q_norm_g, w_q_up, kv_norm_g, w_kv_up) @ w_br_b
    g = jax.nn.sigmoid(gates.astype(jnp.float32))
    g_a, g_b = g[..., :D], g[..., D:]
    merged = (g_a * y_a.astype(jnp.float32) + g_b * y_b.astype(jnp.float32)).astype(h.dtype)
    return merged @ w_out


def grouped_moe(h, w_router, router_bias, w_gate, w_up, w_down):
    B, S, D = h.shape
    t = h.reshape(-1, D)
    scores = jax.nn.sigmoid((t @ w_router).astype(jnp.float32))
    biased = (scores + router_bias.astype(jnp.float32)).reshape(-1, N_GROUPS, EXPERTS_PER_GROUP)
    group_score = lax.top_k(biased, 2)[0].sum(-1)
    _, gidx = lax.top_k(group_score, TOPK_GROUPS)
    gmask = jax.nn.one_hot(gidx, N_GROUPS, dtype=jnp.float32).sum(-2) > 0
    masked = jnp.where(gmask[:, :, None], biased, -jnp.inf).reshape(-1, N_EXPERTS)
    _, eidx = lax.top_k(masked, TOP_K)
    sel = jnp.take_along_axis(scores, eidx, axis=-1)
    w = sel / sel.sum(-1, keepdims=True)
    combine = (jax.nn.one_hot(eidx, N_EXPERTS, dtype=jnp.float32) * w[..., None]).sum(-2)
    y = jnp.zeros(t.shape, jnp.float32)
    for e in range(N_EXPERTS):
        he = jax.nn.silu(t @ w_gate[e]) * (t @ w_up[e])
        y = y + combine[:, e:e + 1] * (he @ w_down[e]).astype(jnp.float32)
    return y.astype(h.dtype).reshape(B, S, D)


def setup_inputs(seed: int = 0) -> dict:
    key = jax.random.key(seed)
    ks = jax.random.split(key, 24)
    f32 = jnp.float32
    D = D_MODEL

    def nrm(k, shape, scale):
        return jax.random.normal(k, shape, f32) * scale

    positions = (jax.random.randint(ks[2], (BATCH, 1), 0, MAX_OFFSET, dtype=jnp.int32)
                 + jnp.arange(SEQ, dtype=jnp.int32)[None, :]).astype(jnp.int32)
    return {
        "x": nrm(ks[0], (BATCH, SEQ, D), 1.0),
        "c": nrm(ks[1], (BATCH, D), 1.0),
        "positions": positions,
        "ada_w": nrm(ks[3], (DEPTH, D, 6 * D), 0.5 * D ** -0.5),
        "ada_b": nrm(ks[4], (DEPTH, 6 * D), 0.02),
        "norm1_g": 1.0 + nrm(ks[5], (DEPTH, D), 0.02),
        "w_in": nrm(ks[6], (DEPTH, D, IN_COLS), D ** -0.5),
        "hg_lb_logits": nrm(ks[7], (DEPTH, HG_HEADS * HG_DK), 1.0),
        "hg_norm_g": 1.0 + nrm(ks[8], (DEPTH, HG_WIDTH), 0.02),
        "q_norm_g": 1.0 + nrm(ks[9], (DEPTH, MLA_Q_LORA), 0.02),
        "w_q_up": nrm(ks[10], (DEPTH, MLA_Q_LORA, MLA_HEADS * MLA_DQK), MLA_Q_LORA ** -0.5),
        "kv_norm_g": 1.0 + nrm(ks[11], (DEPTH, MLA_KV_LORA), 0.02),
        "w_kv_up": nrm(ks[12], (DEPTH, MLA_KV_LORA, MLA_HEADS * (MLA_NOPE + MLA_V)), MLA_KV_LORA ** -0.5),
        "w_br_a": nrm(ks[13], (DEPTH, HG_WIDTH, D), HG_WIDTH ** -0.5),
        "w_br_b": nrm(ks[14], (DEPTH, MLA_WIDTH, D), MLA_WIDTH ** -0.5),
        "w_out": nrm(ks[15], (DEPTH, D, D), D ** -0.5),
        "norm2_g": 1.0 + nrm(ks[16], (DEPTH, D), 0.02),
        "w_router": nrm(ks[17], (D, N_EXPERTS), D ** -0.5),
        "router_bias": nrm(ks[18], (N_EXPERTS,), 0.01),
        "w_gate": nrm(ks[19], (DEPTH, N_EXPERTS, D, D_EXPERT), D ** -0.5),
        "w_up": nrm(ks[20], (DEPTH, N_EXPERTS, D, D_EXPERT), D ** -0.5),
        "w_down": nrm(ks[21], (DEPTH, N_EXPERTS, D_EXPERT, D), D_EXPERT ** -0.5),
        "final_g": 1.0 + nrm(ks[22], (D,), 0.02),
    }


def reference(x, c, positions, ada_w, ada_b, norm1_g, w_in, hg_lb_logits, hg_norm_g,
              q_norm_g, w_q_up, kv_norm_g, w_kv_up, w_br_a, w_br_b, w_out, norm2_g,
              w_router, router_bias, w_gate, w_up, w_down, final_g):
    D = D_MODEL
    lb_soft = jax.nn.softmax(hg_lb_logits.astype(jnp.float32), axis=0)
    lb_all = jnp.cumsum(lb_soft, axis=0) - lb_soft[0:1]
    c_act = jax.nn.silu(c)
    for l in range(DEPTH):
        mod = c_act @ ada_w[l] + ada_b[l]
        sh1, sc1, g1 = mod[:, None, 0:D], mod[:, None, D:2 * D], mod[:, None, 2 * D:3 * D]
        sh2, sc2, g2 = mod[:, None, 3 * D:4 * D], mod[:, None, 4 * D:5 * D], mod[:, None, 5 * D:6 * D]
        h = rmsnorm(x, norm1_g[l]) * (1.0 + sc1) + sh1
        x = x + g1 * token_mix(h, positions, w_in[l], lb_all[l], hg_norm_g[l], q_norm_g[l], w_q_up[l],
                               kv_norm_g[l], w_kv_up[l], w_br_a[l], w_br_b[l], w_out[l])
        h = rmsnorm(x, norm2_g[l]) * (1.0 + sc2) + sh2
        x = x + g2 * grouped_moe(h, w_router, router_bias, w_gate[l], w_up[l], w_down[l])
    return rmsnorm(x, final_g)
```

```cpp
#include <hip/hip_runtime.h>
#include <cstdio>
#include <cstdint>

#define GAS __attribute__((address_space(1)))
#define LAS __attribute__((address_space(3)))
typedef unsigned short bf16_t;
typedef short bf16x8 __attribute__((ext_vector_type(8)));
typedef short s16x4 __attribute__((ext_vector_type(4)));
typedef float f32x2 __attribute__((ext_vector_type(2)));
typedef float f32x4 __attribute__((ext_vector_type(4)));
typedef float f32x16 __attribute__((ext_vector_type(16)));
typedef unsigned u32x2 __attribute__((ext_vector_type(2)));
typedef unsigned u32x4 __attribute__((ext_vector_type(4)));

#ifndef DBG_NOUP
#define DBG_NOUP 0
#endif
#ifndef PH_MASK
#define PH_MASK 0xFFFF
#endif
#define PHEN(k) (((PH_MASK) >> (k)) & 1)
#ifndef MK_PER_PHASE
#define MK_PER_PHASE 0
#endif

constexpr int T = 16384, DM = 1024, NB = 4, SEQ = 4096, DEPTH = 2;
constexpr int NPROJ = 4864, INCOLS = 4768;
constexpr int NE = 16, DE = 512;
constexpr int SLOTROWS = 2 * T + 4096;
constexpr int NWAVES = 8, NTHR = 512;
constexpr float EPS = 1e-6f;

constexpr size_t WS_CTL = 0, CTL_BYTES = 1u << 20;
constexpr size_t WS_MOD = WS_CTL + CTL_BYTES;
constexpr size_t WS_LB = WS_MOD + 2 * 4 * 6144 * 4;
constexpr size_t WS_ROPE = WS_LB + 2 * 512 * 4;
constexpr size_t WS_SSQKV = WS_ROPE + (size_t)T * 16 * 8;
constexpr size_t WS_SSQQ = WS_SSQKV + (size_t)T * 8 * 4;
constexpr size_t WS_AC = WS_SSQQ + (size_t)T * 16 * 4;
constexpr size_t WS_TL = WS_AC + 1024 * 128 * 4;
constexpr size_t WS_WL = WS_TL + (size_t)NE * T * 4;
constexpr size_t WS_TS = WS_WL + (size_t)NE * T * 4;
constexpr size_t WS_WT = WS_TS + (size_t)T * 2 * 4;
constexpr size_t WT_IN = 0, WT_QU = WT_IN + (size_t)NPROJ * 1024 * 2, WT_KV = WT_QU + 768 * 384 * 2, WT_BA = WT_KV + 1024 * 256 * 2,
                 WT_BB = WT_BA + 1024 * 512 * 2, WT_OUT = WT_BB + 1024 * 512 * 2, WT_GU = WT_OUT + 1024 * 1024 * 2,
                 WT_DN = WT_GU + (size_t)NE * 1024 * 1024 * 2, WT_END = WT_DN + (size_t)NE * 1024 * 512 * 2;
constexpr size_t WS_HN = WS_WT + WT_END;
constexpr size_t WS_P = WS_HN + (size_t)T * 1024 * 2;
constexpr size_t P_QH = 0, P_LF = P_QH + (size_t)T * 512 * 2, P_VH = P_LF + (size_t)T * 512 * 2, P_HG = P_VH + (size_t)T * 512 * 2,
                 P_GT = P_HG + (size_t)T * 512 * 2, P_CKV = P_GT + (size_t)T * 2048 * 2, P_CQ = P_CKV + (size_t)T * 256 * 2,
                 P_KPE = P_CQ + (size_t)T * 512 * 2, P_END = P_KPE + (size_t)T * 32 * 2;
constexpr size_t WS_Q = WS_P + P_END;
constexpr size_t WS_KN = WS_Q + (size_t)T * 768 * 2;
constexpr size_t WS_V = WS_KN + (size_t)T * 512 * 2;
constexpr size_t WS_UT = WS_V + (size_t)T * 512 * 2;
constexpr size_t WS_END = WS_UT + (size_t)1024 * 128 * 128 * 2;
constexpr size_t WS_AO = WS_P + P_CQ;
constexpr size_t WS_OA = WS_P + P_LF;
constexpr size_t WS_MG = WS_Q;
constexpr size_t WS_TMP = WS_UT;
constexpr size_t WS_HE = WS_P;
constexpr size_t WS_Y = WS_HE + (size_t)SLOTROWS * 512 * 2;
static_assert(WS_Y + (size_t)SLOTROWS * 1024 * 2 <= WS_P + P_END, "MoE overlay fits the projection set");
static_assert((size_t)T * 1024 * 2 <= (size_t)T * 768 * 2 + (size_t)T * 512 * 2, "MG fits Q|KN");
static_assert(WS_END <= 379290688ull, "workspace map exceeds sum(inputs)");
constexpr int CW_BAR = 4096;
constexpr int CW_CNT = 16384;

constexpr int LDS_SCR = 0, LDS_SCR_BYTES = 131072, LDS_MISC = 131072, LDS_BYTES = 147456;

typedef __bf16 bf16x2_t __attribute__((ext_vector_type(2)));
__device__ __forceinline__ unsigned cvt_pk_bf16(float lo, float hi) { f32x2 v = {lo, hi}; bf16x2_t b = __builtin_convertvector(v, bf16x2_t); return __builtin_bit_cast(unsigned, b); }
__device__ __forceinline__ float bf2f(unsigned short h) { return __uint_as_float((unsigned)h << 16); }
__device__ __forceinline__ float bflo(unsigned w) { return __uint_as_float(w << 16); }
__device__ __forceinline__ float bfhi(unsigned w) { return __uint_as_float(w & 0xffff0000u); }
__device__ __forceinline__ float fexp(float x) { return __builtin_amdgcn_exp2f(x * 1.4426950408889634f); }
__device__ __forceinline__ float fsigmoid(float x) { return __builtin_amdgcn_rcpf(1.f + fexp(-x)); }
__device__ __forceinline__ float fsilu(float x) { return x * fsigmoid(x); }
__device__ __forceinline__ float flog(float x) { return __builtin_amdgcn_logf(x) * 0.6931471805599453f; }
__device__ __forceinline__ u32x4 pack8(f32x4 a, f32x4 b) { u32x4 w; w.x = cvt_pk_bf16(a.x, a.y); w.y = cvt_pk_bf16(a.z, a.w); w.z = cvt_pk_bf16(b.x, b.y); w.w = cvt_pk_bf16(b.z, b.w); return w; }
__device__ __forceinline__ void unpack8(u32x4 w, f32x4& a, f32x4& b) { a.x = bflo(w.x); a.y = bfhi(w.x); a.z = bflo(w.y); a.w = bfhi(w.y); b.x = bflo(w.z); b.y = bfhi(w.z); b.z = bflo(w.w); b.w = bfhi(w.w); }
__device__ __forceinline__ float wave_sum(float v) {
#pragma unroll
    for (int o = 1; o < 64; o <<= 1) v += __shfl_xor(v, o);
    return v;
}
#define LDS_WAIT() asm volatile("s_waitcnt lgkmcnt(0)" ::: "memory")
#define VM_WAIT() asm volatile("s_waitcnt vmcnt(0)" ::: "memory")

#define XB_TMO      128
#define XB_XCNT(j)  (256  + 64 * (j))
#define XB_XSUB(j)  (1280 + 64 * (j))
#define XB_XGEN(j)  (2304 + 64 * (j))
#define XB_TOP      3328
#define XB_TOPGEN   3392
#define XCD_BAR_WORDS 3456
#define XB_SPIN_CAP (1u << 18)
__device__ __forceinline__ unsigned xb_ld(unsigned* p)              { return __hip_atomic_load(p, __ATOMIC_RELAXED, __HIP_MEMORY_SCOPE_AGENT); }
__device__ __forceinline__ unsigned xb_add(unsigned* p, unsigned v) { return __hip_atomic_fetch_add(p, v, __ATOMIC_RELAXED, __HIP_MEMORY_SCOPE_AGENT); }
__device__ __forceinline__ unsigned xb_xcc_id() { return (unsigned)__builtin_amdgcn_s_getreg((3 << 11) | 20) & 0xFu; }
#define XB_SPIN(cond, bar) do { unsigned _sp = 0; while (cond) { __builtin_amdgcn_s_sleep(1); \
    if ((++_sp & 255u) == 0u) { if (xb_ld(&(bar)[XB_TMO])) break; if (_sp > XB_SPIN_CAP) { atomicAdd(&(bar)[XB_TMO], 1u); break; } } } } while (0)
struct XcdBarrier { unsigned* bar; unsigned x; volatile LAS unsigned* st; };
__device__ __forceinline__ XcdBarrier xcd_barrier_post(unsigned* bar, volatile LAS unsigned* st) {
    XcdBarrier b; b.bar = bar; b.x = xb_xcc_id(); b.st = st;
    if (threadIdx.x == 0) (void)xb_add(&bar[XB_XCNT(b.x)], 1u);
    return b;
}
__device__ __forceinline__ void xcd_barrier_complete(unsigned* bar, unsigned x, unsigned& nloc, unsigned& nx) {
    const unsigned G = gridDim.x * gridDim.y * gridDim.z;
    unsigned sum, cnt, mine, sp = 0u;
    for (;;) {
        sum = 0u; cnt = 0u; mine = 0u;
#pragma unroll
        for (unsigned j = 0; j < 16; ++j) { const unsigned c = xb_ld(&bar[XB_XCNT(j)]); sum += c; cnt += (c > 0u) ? 1u : 0u; mine = (j == x) ? c : mine; }
        if (sum == G) break;
        __builtin_amdgcn_s_sleep(1);
        if ((++sp & 255u) == 0u) { if (xb_ld(&bar[XB_TMO])) break; if (sp > XB_SPIN_CAP) { atomicAdd(&bar[XB_TMO], 1u); break; } }
    }
    nloc = mine > 0u ? mine : 1u; nx = cnt > 0u ? cnt : 1u;
}
__device__ __forceinline__ void xcd_barrier(const XcdBarrier& b) {
    asm volatile("s_waitcnt vmcnt(0)" ::: "memory");
    __syncthreads();
    if (threadIdx.x == 0) {
        unsigned* bar = b.bar;
        __builtin_amdgcn_s_waitcnt(0);
        unsigned nloc = b.st[0], nx = b.st[1];
        if (nloc == 0u) { xcd_barrier_complete(bar, b.x, nloc, nx); b.st[0] = nloc; b.st[1] = nx; }
        const unsigned old = xb_add(&bar[XB_XSUB(b.x)], 1u);
        const unsigned gen = old / nloc;
        if (old + 1u == (gen + 1u) * nloc) {
            __builtin_amdgcn_fence(__ATOMIC_RELEASE, "agent");
            asm volatile("s_waitcnt vmcnt(0)" ::: "memory");
            const unsigned og = xb_add(&bar[XB_TOP], 1u);
            const unsigned tg = og / nx;
            if (og + 1u == (tg + 1u) * nx) xb_add(&bar[XB_TOPGEN], 1u);
            else XB_SPIN(xb_ld(&bar[XB_TOPGEN]) == tg, bar);
            __builtin_amdgcn_fence(__ATOMIC_ACQUIRE, "agent");
            xb_add(&bar[XB_XGEN(b.x)], 1u);
            asm volatile("s_waitcnt vmcnt(0)" ::: "memory");
        } else {
            XB_SPIN(xb_ld(&bar[XB_XGEN(b.x)]) == gen, bar);
            __builtin_amdgcn_fence(__ATOMIC_ACQUIRE, "agent");
            asm volatile("s_waitcnt vmcnt(0)" ::: "memory");
        }
    }
    __syncthreads();
}

namespace pg8 {
constexpr int BM = 256, BK = 64, HALF = 128, HTB = HALF * BK * 2, STAGE_BYTES = 8 * HTB, NXCD = 8, WGM = 8;
__host__ __device__ __forceinline__ int lds_byte(int r, int c) { const int st = (r >> 4) * 2 + (c >> 5), rr = r & 15, cc = c & 31, ob = rr * 64 + cc * 2; return st * 1024 + (ob ^ (((ob >> 9) & 1) << 5)); }
__host__ __device__ __forceinline__ void stage_rc(int b, int& R, int& C) { const int st = b / 1024, sb = b % 1024, swz = sb ^ (((sb >> 9) & 1) << 5); R = (st >> 1) * 16 + swz / 64; C = (st & 1) * 32 + (swz % 64) / 2; }
__host__ __device__ __forceinline__ int perm32(int rho) { const int n = rho >> 4, i = rho & 15; return 8 * (i >> 2) + 4 * n + (i & 3); }

struct Unit { int pm, pn, e, rt, nv; };

struct StaticOrder {
    int nM, nN, nwg, G, c;
    __device__ __forceinline__ void init(int M, int N, int G_, int c_) { nM = M / BM; nN = N / BM; nwg = nM * nN; G = G_; c = c_; }
    __device__ __forceinline__ bool next(int i, Unit& u) const {
        const long L = (long)i * G + c; if (L >= nwg) return false;
        int wgid = (int)L; { const int q = nwg / NXCD, r = nwg % NXCD, xcd = wgid % NXCD, off = wgid / NXCD; wgid = (xcd < r ? xcd * (q + 1) : r * (q + 1) + (xcd - r) * q) + off; }
        const int nig = WGM * nN, gid = wgid / nig, fm = gid * WGM, gsz = (nM - fm) < WGM ? (nM - fm) : WGM;
        u.pm = fm + ((wgid % nig) % gsz); u.pn = (wgid % nig) / gsz; return true;
    }
};

template <class Epi, class Prob>
__device__ __forceinline__ void gemm_phase(LAS unsigned char* lds, const Prob& P, const Epi& E, const int tid) {
    const int wid = __builtin_amdgcn_readfirstlane(tid >> 6), lane = tid & 63, wr = wid >> 2, wc = wid & 3, fr = lane & 15, fq = lane >> 4;
    const int nt = P.K / BK;
    unsigned voffB[2];
#pragma unroll
    for (int i = 0; i < 2; ++i) { int R, C; stage_rc(tid * 16 + i * 8192, R, C); const int Rb = (R & ~31) + perm32(R & 31); voffB[i] = (unsigned)(Rb * P.ldb + C) * 2u; }
    const size_t kstep = (size_t)(BK * 2);
    const size_t hstepB = (size_t)HALF * P.ldb * 2;
    const unsigned ldsw = (unsigned)wid * 1024u;
    const int aoff = lds_byte(wr * 64 + fr, fq * 8), boff = lds_byte(wc * 32 + fr, fq * 8);
#define PG8_SA(b, h) (((b) * 2 + (h)) * HTB)
#define PG8_SB(b, h) ((4 + (b) * 2 + (h)) * HTB)
#define PG8_STAGE(bufoff, gbase, voff) do { _Pragma("unroll") for (int _i = 0; _i < 2; ++_i) \
        __builtin_amdgcn_global_load_lds((const unsigned*)((const char*)(gbase) + (voff)[_i]), (LAS unsigned*)(lds + (bufoff) + ldsw + _i * 8192), 16, 0, 0); } while (0)
#define PG8_LDA(dst, b, h) do { _Pragma("unroll") for (int m = 0; m < 4; ++m) _Pragma("unroll") for (int k = 0; k < 2; ++k) dst[m][k] = *(const LAS bf16x8*)(lds + PG8_SA(b, h) + aoff + m * 2048 + k * 1024); } while (0)
#define PG8_LDB(dst, b, h) do { _Pragma("unroll") for (int n = 0; n < 2; ++n) _Pragma("unroll") for (int k = 0; k < 2; ++k) dst[n][k] = *(const LAS bf16x8*)(lds + PG8_SB(b, h) + boff + n * 2048 + k * 1024); } while (0)
#define PG8_MMA(ai, bj, At, Bt) do { __builtin_amdgcn_s_setprio(1); _Pragma("unroll") for (int m = 0; m < 4; ++m) _Pragma("unroll") for (int n = 0; n < 2; ++n) _Pragma("unroll") for (int k = 0; k < 2; ++k) \
        acc[ai][bj][m][n] = __builtin_amdgcn_mfma_f32_16x16x32_bf16(Bt[n][k], At[m][k], acc[ai][bj][m][n], 0, 0, 0); __builtin_amdgcn_s_setprio(0); } while (0)
#define PG8_WAIT_V(n) asm volatile("s_waitcnt vmcnt(" #n ")" ::: "memory")
#define PG8_WAIT_L(n) asm volatile("s_waitcnt lgkmcnt(" #n ")" ::: "memory")
#define PG8_BAR __builtin_amdgcn_s_barrier()
#define PG8_SCHED __builtin_amdgcn_sched_barrier(0)
    Unit cur, nxt; int ui = 0;
    if (!P.next(0, cur)) return;
    f32x4 acc[2][2][4][2];
#pragma unroll
    for (int a = 0; a < 2; ++a)
#pragma unroll
        for (int b = 0; b < 2; ++b)
#pragma unroll
            for (int m = 0; m < 4; ++m)
#pragma unroll
                for (int n = 0; n < 2; ++n) acc[a][b][m][n] = (f32x4){0.f, 0.f, 0.f, 0.f};
    bf16x8 At[4][2], B0[2][2], B1[2][2];
    unsigned oc[2][2];
    P.a_off(cur, tid, oc);
    const char* const Ab = P.A;
    const char* cB = P.b_ptr(cur);
    PG8_STAGE(PG8_SB(0, 0), cB, voffB); PG8_STAGE(PG8_SB(0, 1), cB + hstepB, voffB); PG8_STAGE(PG8_SA(0, 0), Ab, oc[0]); PG8_STAGE(PG8_SA(0, 1), Ab, oc[1]);
    if (wr == 1) PG8_BAR;
    PG8_WAIT_V(2); PG8_BAR;
    PG8_STAGE(PG8_SB(1, 0), cB + kstep, voffB); PG8_STAGE(PG8_SA(1, 0), Ab + kstep, oc[0]); PG8_STAGE(PG8_SB(1, 1), cB + hstepB + kstep, voffB);
    PG8_WAIT_V(6); PG8_BAR;
    for (;;) {
        const bool has_next = P.next(ui + 1, nxt);
        const char* nB = has_next ? P.b_ptr(nxt) : cB;
        for (int t = 0; t < nt; t += 2) {
            const bool last = (t == nt - 2);
            const char* a1 = Ab + (size_t)(t + 1) * kstep;
            const char* a2 = last ? Ab : Ab + (size_t)(t + 2) * kstep; const char* b2 = last ? nB : cB + (size_t)(t + 2) * kstep;
            const char* a3 = a2 + kstep; const char* b3 = b2 + kstep;
            const char* b2h = b2 + hstepB; const char* b3h = b3 + hstepB;
            asm volatile("" : "+s"(a1), "+s"(a2), "+s"(a3));
            asm volatile("" : "+s"(b2), "+s"(b3), "+s"(b2h), "+s"(b3h));
            unsigned o2[2][2];
#pragma unroll
            for (int h = 0; h < 2; ++h)
#pragma unroll
                for (int i = 0; i < 2; ++i) o2[h][i] = oc[h][i];
            if (last && has_next) P.a_off(nxt, tid, o2);
            PG8_LDB(B0, 0, 0); PG8_LDB(B1, 0, 1); PG8_SCHED; PG8_LDA(At, 0, 0); PG8_STAGE(PG8_SA(1, 1), a1, oc[1]);
            PG8_WAIT_V(8); PG8_WAIT_L(0); PG8_BAR; PG8_MMA(0, 0, At, B0); PG8_MMA(0, 1, At, B1); PG8_BAR; PG8_SCHED;
            PG8_LDA(At, 0, 1); PG8_STAGE(PG8_SB(0, 0), b2, voffB); PG8_STAGE(PG8_SB(0, 1), b2h, voffB); PG8_STAGE(PG8_SA(0, 0), a2, o2[0]);
            PG8_WAIT_V(8); PG8_WAIT_L(0); PG8_BAR; PG8_MMA(1, 0, At, B0); PG8_MMA(1, 1, At, B1); PG8_BAR; PG8_SCHED;
            PG8_LDB(B0, 1, 0); PG8_LDB(B1, 1, 1); PG8_SCHED; PG8_LDA(At, 1, 0); PG8_STAGE(PG8_SA(0, 1), a2, o2[1]);
            PG8_WAIT_V(8); PG8_WAIT_L(0); PG8_BAR; PG8_MMA(0, 0, At, B0); PG8_MMA(0, 1, At, B1); PG8_BAR; PG8_SCHED;
            PG8_LDA(At, 1, 1); PG8_STAGE(PG8_SB(1, 0), b3, voffB); PG8_STAGE(PG8_SB(1, 1), b3h, voffB); PG8_STAGE(PG8_SA(1, 0), a3, o2[0]);
            PG8_WAIT_V(8); PG8_WAIT_L(0); PG8_BAR; PG8_MMA(1, 0, At, B0); PG8_MMA(1, 1, At, B1); PG8_BAR; PG8_SCHED;
        }
        if (wr == 0) PG8_BAR;
        E(acc, cur, wr, wc, fr, fq);
        if (!has_next) break;
#pragma unroll
        for (int a = 0; a < 2; ++a)
#pragma unroll
            for (int b = 0; b < 2; ++b)
#pragma unroll
                for (int m = 0; m < 4; ++m)
#pragma unroll
                    for (int n = 0; n < 2; ++n) acc[a][b][m][n] = (f32x4){0.f, 0.f, 0.f, 0.f};
        cur = nxt; cB = nB; ++ui;
        P.a_off(cur, tid, oc);
        if (wr == 1) PG8_BAR;
    }
    PG8_WAIT_V(0);
    PG8_BAR;
#undef PG8_SA
#undef PG8_SB
#undef PG8_STAGE
#undef PG8_LDA
#undef PG8_LDB
#undef PG8_MMA
#undef PG8_WAIT_V
#undef PG8_WAIT_L
#undef PG8_BAR
#undef PG8_SCHED
}

struct ProbDense {
    const char* A; const char* Bt; int lda, ldb, K; StaticOrder S;
    __device__ __forceinline__ bool next(int i, Unit& u) const { u.e = 0; u.rt = 0; u.nv = 256; return S.next(i, u); }
    __device__ __forceinline__ void a_off(const Unit& u, int tid, unsigned (&o)[2][2]) const {
#pragma unroll
        for (int i = 0; i < 2; ++i) { int R, C; stage_rc(tid * 16 + i * 8192, R, C);
#pragma unroll
            for (int h = 0; h < 2; ++h) o[h][i] = (unsigned)((u.pm * 256 + h * 128 + R) * lda + C) * 2u; }
    }
    __device__ __forceinline__ const char* b_ptr(const Unit& u) const { return Bt + (size_t)u.pn * 256 * ldb * 2; }
};
struct ProbMoeGU {
    const char* A; const char* Bt; const int* TL; const LAS int* ul; int nun; int lda, ldb, K;
    __device__ __forceinline__ bool next(int i, Unit& u) const { if (i >= nun) return false; const LAS int* p = ul + i * 8; u.pm = __builtin_amdgcn_readfirstlane(p[0]); u.pn = __builtin_amdgcn_readfirstlane(p[1]); u.e = __builtin_amdgcn_readfirstlane(p[2]); u.rt = __builtin_amdgcn_readfirstlane(p[3]); u.nv = __builtin_amdgcn_readfirstlane(p[4]); return true; }
    __device__ __forceinline__ void a_off(const Unit& u, int tid, unsigned (&o)[2][2]) const {
#pragma unroll
        for (int i = 0; i < 2; ++i) { int R, C; stage_rc(tid * 16 + i * 8192, R, C);
#pragma unroll
            for (int h = 0; h < 2; ++h) { const int idx = h * 128 + R; const int tok = idx < u.nv ? TL[u.e * T + u.rt * 256 + idx] : 0; o[h][i] = (unsigned)(tok * 1024 + C) * 2u; } }
    }
    __device__ __forceinline__ const char* b_ptr(const Unit& u) const { return Bt + ((size_t)u.e * 1024 + (size_t)u.pn * 256) * 1024 * 2; }
};
struct ProbMoeDown {
    const char* A; const char* Bt; const LAS int* ul; int nun; int lda, ldb, K;
    __device__ __forceinline__ bool next(int i, Unit& u) const { if (i >= nun) return false; const LAS int* p = ul + i * 8; u.pm = __builtin_amdgcn_readfirstlane(p[0]); u.pn = __builtin_amdgcn_readfirstlane(p[1]); u.e = __builtin_amdgcn_readfirstlane(p[2]); u.rt = __builtin_amdgcn_readfirstlane(p[3]); u.nv = __builtin_amdgcn_readfirstlane(p[4]); return true; }
    __device__ __forceinline__ void a_off(const Unit& u, int tid, unsigned (&o)[2][2]) const {
#pragma unroll
        for (int i = 0; i < 2; ++i) { int R, C; stage_rc(tid * 16 + i * 8192, R, C);
#pragma unroll
            for (int h = 0; h < 2; ++h) o[h][i] = (unsigned)((u.pm * 256 + h * 128 + R) * 512 + C) * 2u; }
    }
    __device__ __forceinline__ const char* b_ptr(const Unit& u) const { return Bt + ((size_t)u.e * 1024 + (size_t)u.pn * 256) * 512 * 2; }
};

#define EPI_ARGS const f32x4 (&acc)[2][2][4][2], const Unit& u, int wr, int wc, int fr, int fq
struct EpiProj {
    bf16_t *QH, *LF, *VH, *HG, *GT, *CKV, *CQ, *KPE; float *SSQKV, *SSQQ; const float* lb; const f32x2* rope;
    __device__ __forceinline__ void operator()(EPI_ARGS) const {
        const int pn = u.pn;
        bf16_t* ob; int ldc, coff, mode;
        if (pn < 8) { const int g = pn >> 1; ob = g == 0 ? QH : g == 1 ? LF : g == 2 ? VH : HG; ldc = 512; coff = (pn & 1) * 256; mode = g == 0 ? 0 : g == 1 ? 1 : g == 2 ? 2 : 3; }
        else if (pn < 16) { ob = GT; ldc = 2048; coff = (pn - 8) * 256; mode = 4; }
        else if (pn == 16) { ob = CKV; ldc = 256; coff = 0; mode = 2; }
        else { ob = CQ; ldc = 512; coff = (pn - 17) * 256; mode = 2; }
#pragma unroll
        for (int ai = 0; ai < 2; ++ai)
#pragma unroll
            for (int m = 0; m < 4; ++m) {
                const int row = u.pm * 256 + ai * 128 + wr * 64 + m * 16 + fr;
#pragma unroll
                for (int bj = 0; bj < 2; ++bj) {
                    const int lc = bj * 128 + wc * 32 + 8 * fq;
                    f32x4 v0 = acc[ai][bj][m][0], v1 = acc[ai][bj][m][1];
                    if (mode == 0) {
#pragma unroll
                        for (int j = 0; j < 4; ++j) { v0[j] = fsilu(v0[j]) * 0.08838834764831845f; v1[j] = fsilu(v1[j]) * 0.08838834764831845f; }
                    } else if (mode == 1) {
                        const f32x4 l0 = *(const f32x4*)(lb + coff + lc), l1 = *(const f32x4*)(lb + coff + lc + 4);
#pragma unroll
                        for (int j = 0; j < 4; ++j) { v0[j] = flog(l0[j] + (1.f - l0[j]) * fsigmoid(v0[j])); v1[j] = flog(l1[j] + (1.f - l1[j]) * fsigmoid(v1[j])); }
                    } else if (mode == 3) {
#pragma unroll
                        for (int j = 0; j < 4; ++j) { v0[j] = fsilu(v0[j]); v1[j] = fsilu(v1[j]); }
                    } else if (mode == 4) {
#pragma unroll
                        for (int j = 0; j < 4; ++j) { v0[j] = fsigmoid(v0[j]); v1[j] = fsigmoid(v1[j]); }
                    }
                    *(u32x4*)(ob + (size_t)row * ldc + coff + lc) = pack8(v0, v1);
                    if (pn >= 16) {
                        float ss = 0.f;
#pragma unroll
                        for (int j = 0; j < 4; ++j) ss += v0[j] * v0[j] + v1[j] * v1[j];
                        ss += __shfl_xor(ss, 16); ss += __shfl_xor(ss, 32);
                        if (fq == 0) {
                            if (pn == 16) SSQKV[(size_t)row * 8 + bj * 4 + wc] = ss;
                            else SSQQ[(size_t)row * 16 + ((pn - 17) * 2 + bj) * 4 + wc] = ss;
                        }
                        if (pn == 18 && bj == 1 && wc == 0) {
                            const f32x2* rp = rope + (size_t)row * 16 + 4 * fq;
                            const f32x2 c0 = rp[0], c1 = rp[1], c2 = rp[2], c3 = rp[3];
                            f32x4 r0, r1;
                            r0.x = v0.x * c0.x - v0.y * c0.y; r0.y = v0.x * c0.y + v0.y * c0.x; r0.z = v0.z * c1.x - v0.w * c1.y; r0.w = v0.z * c1.y + v0.w * c1.x;
                            r1.x = v1.x * c2.x - v1.y * c2.y; r1.y = v1.x * c2.y + v1.y * c2.x; r1.z = v1.z * c3.x - v1.w * c3.y; r1.w = v1.z * c3.y + v1.w * c3.x;
                            *(u32x4*)(KPE + (size_t)row * 32 + 8 * fq) = pack8(r0, r1);
                        }
                    }
                    asm volatile("" ::: "memory");
                }
            }
    }
};
struct EpiQup {
    bf16_t* Q; const float* SSQQ; const f32x2* rope;
    __device__ __forceinline__ void operator()(EPI_ARGS) const {
#pragma unroll
        for (int ai = 0; ai < 2; ++ai)
#pragma unroll
            for (int m = 0; m < 4; ++m) {
                const int row = u.pm * 256 + ai * 128 + wr * 64 + m * 16 + fr;
                const f32x4 s0 = *(const f32x4*)(SSQQ + (size_t)row * 16), s1 = *(const f32x4*)(SSQQ + (size_t)row * 16 + 4), s2 = *(const f32x4*)(SSQQ + (size_t)row * 16 + 8);
                const float ss = ((s0.x + s0.y) + (s0.z + s0.w)) + ((s1.x + s1.y) + (s1.z + s1.w)) + ((s2.x + s2.y) + (s2.z + s2.w));
                const float rstd = __builtin_amdgcn_rsqf(ss * (1.f / 384.f) + EPS);
#pragma unroll
                for (int bj = 0; bj < 2; ++bj) {
                    const int lc = bj * 128 + wc * 32 + 8 * fq;
                    const int g = u.pn * 8 + bj * 4 + wc;
                    f32x4 v0 = acc[ai][bj][m][0] * rstd, v1 = acc[ai][bj][m][1] * rstd;
                    if (g % 3 == 2) {
                        const f32x2* rp = rope + (size_t)row * 16 + 4 * fq;
                        const f32x2 c0 = rp[0], c1 = rp[1], c2 = rp[2], c3 = rp[3];
                        f32x4 r0, r1;
                        r0.x = v0.x * c0.x - v0.y * c0.y; r0.y = v0.x * c0.y + v0.y * c0.x; r0.z = v0.z * c1.x - v0.w * c1.y; r0.w = v0.z * c1.y + v0.w * c1.x;
                        r1.x = v1.x * c2.x - v1.y * c2.y; r1.y = v1.x * c2.y + v1.y * c2.x; r1.z = v1.z * c3.x - v1.w * c3.y; r1.w = v1.z * c3.y + v1.w * c3.x;
                        v0 = r0; v1 = r1;
                    }
                    *(u32x4*)(Q + (size_t)row * 768 + u.pn * 256 + lc) = pack8(v0, v1);
                    asm volatile("" ::: "memory");
                }
            }
    }
};
struct EpiKVup {
    bf16_t *KN, *V; const float* SSQKV;
    __device__ __forceinline__ void operator()(EPI_ARGS) const {
        bf16_t* ob = u.pn < 2 ? KN : V; const int coff = (u.pn & 1) * 256;
#pragma unroll
        for (int ai = 0; ai < 2; ++ai)
#pragma unroll
            for (int m = 0; m < 4; ++m) {
                const int row = u.pm * 256 + ai * 128 + wr * 64 + m * 16 + fr;
                const f32x4 s0 = *(const f32x4*)(SSQKV + (size_t)row * 8), s1 = *(const f32x4*)(SSQKV + (size_t)row * 8 + 4);
                const float ss = ((s0.x + s0.y) + (s0.z + s0.w)) + ((s1.x + s1.y) + (s1.z + s1.w));
                const float rstd = __builtin_amdgcn_rsqf(ss * (1.f / 256.f) + EPS);
#pragma unroll
                for (int bj = 0; bj < 2; ++bj) {
                    const int lc = bj * 128 + wc * 32 + 8 * fq;
                    *(u32x4*)(ob + (size_t)row * 512 + coff + lc) = pack8(acc[ai][bj][m][0] * rstd, acc[ai][bj][m][1] * rstd);
                }
                asm volatile("" ::: "memory");
            }
    }
};
struct EpiBr1 {
    bf16_t* O; const bf16_t* GT;
    __device__ __forceinline__ void operator()(EPI_ARGS) const {
#pragma unroll
        for (int ai = 0; ai < 2; ++ai)
#pragma unroll
            for (int m = 0; m < 4; ++m) {
                const int row = u.pm * 256 + ai * 128 + wr * 64 + m * 16 + fr;
#pragma unroll
                for (int bj = 0; bj < 2; ++bj) {
                    const int col = u.pn * 256 + bj * 128 + wc * 32 + 8 * fq;
                    f32x4 g0, g1; unpack8(*(const u32x4*)(GT + (size_t)row * 2048 + col), g0, g1);
                    *(u32x4*)(O + (size_t)row * 1024 + col) = pack8(acc[ai][bj][m][0] * g0, acc[ai][bj][m][1] * g1);
                }
                asm volatile("" ::: "memory");
            }
    }
};
struct EpiBr2 {
    bf16_t* O; const bf16_t* TMP; const bf16_t* GT;
    __device__ __forceinline__ void operator()(EPI_ARGS) const {
#pragma unroll
        for (int ai = 0; ai < 2; ++ai)
#pragma unroll
            for (int m = 0; m < 4; ++m) {
                const int row = u.pm * 256 + ai * 128 + wr * 64 + m * 16 + fr;
#pragma unroll
                for (int bj = 0; bj < 2; ++bj) {
                    const int col = u.pn * 256 + bj * 128 + wc * 32 + 8 * fq;
                    f32x4 g0, g1, t0, t1; unpack8(*(const u32x4*)(GT + (size_t)row * 2048 + 1024 + col), g0, g1); unpack8(*(const u32x4*)(TMP + (size_t)row * 1024 + col), t0, t1);
                    *(u32x4*)(O + (size_t)row * 1024 + col) = pack8(t0 + acc[ai][bj][m][0] * g0, t1 + acc[ai][bj][m][1] * g1);
                    asm volatile("" ::: "memory");
                }
            }
    }
};
struct EpiOut {
    const float* xin; float* xout; const float* g1;
    __device__ __forceinline__ void operator()(EPI_ARGS) const {
#pragma unroll
        for (int ai = 0; ai < 2; ++ai)
#pragma unroll
            for (int m = 0; m < 4; ++m) {
                const int row = u.pm * 256 + ai * 128 + wr * 64 + m * 16 + fr;
                const float* gp = g1 + (size_t)(row >> 12) * 6144;
#pragma unroll
                for (int bj = 0; bj < 2; ++bj) {
                    const int col = u.pn * 256 + bj * 128 + wc * 32 + 8 * fq;
                    const size_t o = (size_t)row * 1024 + col;
                    const f32x4 x0 = *(const f32x4*)(xin + o), x1 = *(const f32x4*)(xin + o + 4);
                    const f32x4 ga = *(const f32x4*)(gp + col), gb = *(const f32x4*)(gp + col + 4);
                    *(f32x4*)(xout + o) = x0 + ga * acc[ai][bj][m][0];
                    *(f32x4*)(xout + o + 4) = x1 + gb * acc[ai][bj][m][1];
                    asm volatile("" ::: "memory");
                }
            }
    }
};
struct EpiGU {
    bf16_t* HE;
    __device__ __forceinline__ void operator()(EPI_ARGS) const {
#pragma unroll
        for (int ai = 0; ai < 2; ++ai)
#pragma unroll
            for (int m = 0; m < 4; ++m) {
                const int row = u.pm * 256 + ai * 128 + wr * 64 + m * 16 + fr;
                f32x4 g0 = acc[ai][0][m][0], g1 = acc[ai][0][m][1];
                const f32x4 u0 = acc[ai][1][m][0], u1 = acc[ai][1][m][1];
#pragma unroll
                for (int j = 0; j < 4; ++j) { g0[j] = fsilu(g0[j]) * u0[j]; g1[j] = fsilu(g1[j]) * u1[j]; }
                *(u32x4*)(HE + (size_t)row * 512 + u.pn * 128 + wc * 32 + 8 * fq) = pack8(g0, g1);
            }
    }
};
struct EpiDown {
    bf16_t* Y; const float* WL;
    __device__ __forceinline__ void operator()(EPI_ARGS) const {
#pragma unroll
        for (int ai = 0; ai < 2; ++ai)
#pragma unroll
            for (int m = 0; m < 4; ++m) {
                const int idx = ai * 128 + wr * 64 + m * 16 + fr;
                const int row = u.pm * 256 + idx;
                const float w = idx < u.nv ? WL[u.e * T + u.rt * 256 + idx] : 0.f;
#pragma unroll
                for (int bj = 0; bj < 2; ++bj) {
                    const int col = u.pn * 256 + bj * 128 + wc * 32 + 8 * fq;
                    *(u32x4*)(Y + (size_t)row * 1024 + col) = pack8(acc[ai][bj][m][0] * w, acc[ai][bj][m][1] * w);
                }
            }
    }
};
}

namespace att {
constexpr int NW = 8, QBLK = 32, KVBLK = 64;
constexpr float SCALE = 0.10206207261596575f;
constexpr float THR = 8.f;
constexpr int SHM_V = 8192, SHM_K = 16384;
constexpr int OFF_V = 0, OFF_K = 2 * SHM_V, OFF_WS = OFF_K + 2 * SHM_K;
#define KSWZ(row, colB) ((row) * 256 + ((colB) ^ (((row) & 7) << 4)))
#define SBAR() __builtin_amdgcn_sched_barrier(0)
__device__ __forceinline__ int crow(int r, int hi) { return (r & 3) + 8 * (r >> 2) + 4 * hi; }
__device__ __forceinline__ unsigned cvtpk(float lo, float hi) { return cvt_pk_bf16(lo, hi); }
__device__ __forceinline__ void partialSM(f32x16& p0, f32x16& p1, float& m_reg, float& mn, float& alpha) {
  constexpr float C = SCALE * 1.4426950408889634f;
  float pmax = p0[0];
#pragma unroll
  for (int r = 1; r < 16; ++r) pmax = fmaxf(pmax, p0[r]);
#pragma unroll
  for (int r = 0; r < 16; ++r) pmax = fmaxf(pmax, p1[r]);
  { auto rr = __builtin_amdgcn_permlane32_swap(__float_as_uint(pmax), __float_as_uint(pmax), false, false);
    pmax = fmaxf(__uint_as_float(rr[0]), __uint_as_float(rr[1])); }
  if (__builtin_expect(__all(pmax - m_reg <= THR / SCALE), 1)) { mn = m_reg; alpha = 1.f; }
  else { mn = fmaxf(m_reg, pmax); alpha = __builtin_amdgcn_exp2f((m_reg - mn) * C); m_reg = mn; }
  float mnC = -mn * C;
#pragma unroll
  for (int r = 0; r < 16; ++r) p0[r] = fmaf(p0[r], C, mnC);
#pragma unroll
  for (int r = 0; r < 16; ++r) p1[r] = fmaf(p1[r], C, mnC);
#pragma unroll
  for (int r = 0; r < 16; ++r) p0[r] = __builtin_amdgcn_exp2f(p0[r]);
}
__device__ __forceinline__ void finishSM(f32x16& p0, f32x16& p1, float alpha, float& l_reg, bf16x8& pa0, bf16x8& pa1, bf16x8& pa2, bf16x8& pa3) {
#pragma unroll
  for (int r = 0; r < 16; ++r) p1[r] = __builtin_amdgcn_exp2f(p1[r]);
  float ps = 0;
#pragma unroll
  for (int r = 0; r < 16; ++r) ps += p0[r];
#pragma unroll
  for (int r = 0; r < 16; ++r) ps += p1[r];
  { auto rr = __builtin_amdgcn_permlane32_swap(__float_as_uint(ps), __float_as_uint(ps), false, false);
    ps = __uint_as_float(rr[0]) + __uint_as_float(rr[1]); }
  l_reg = l_reg * alpha + ps;
#define PK4(P, BASE, OUT) do { unsigned a0 = cvtpk(P[BASE + 0], P[BASE + 1]), a1 = cvtpk(P[BASE + 2], P[BASE + 3]);   \
    unsigned b0 = cvtpk(P[BASE + 4], P[BASE + 5]), b1 = cvtpk(P[BASE + 6], P[BASE + 7]);                              \
    auto r0 = __builtin_amdgcn_permlane32_swap(a0, b0, false, false); auto r1 = __builtin_amdgcn_permlane32_swap(a1, b1, false, false); \
    u32x4 w = {r0[0], r1[0], r0[1], r1[1]}; OUT = __builtin_bit_cast(bf16x8, w); } while (0)
  PK4(p0, 0, pa0); PK4(p0, 8, pa1); PK4(p1, 0, pa2); PK4(p1, 8, pa3);
#undef PK4
}
__device__ __forceinline__ void qkt(f32x16& p0, f32x16& p1, const LAS char* Ks, const bf16x8* qr, int r32, int hi) {
  p0 = f32x16{}; p1 = f32x16{};
#pragma unroll
  for (int d0 = 0; d0 < 6; ++d0) { const int cb = (d0 * 16 + hi * 8) * 2;
    const bf16x8 b0 = *(const LAS bf16x8*)(Ks + KSWZ(r32, cb));
    const bf16x8 b1 = *(const LAS bf16x8*)(Ks + KSWZ(32 + r32, cb));
    p0 = __builtin_amdgcn_mfma_f32_32x32x16_bf16(b0, qr[d0], p0, 0, 0, 0);
    p1 = __builtin_amdgcn_mfma_f32_32x32x16_bf16(b1, qr[d0], p1, 0, 0, 0); }
}
__device__ __forceinline__ int v_st(int k, int c) { const int kk = (k & ~0xC) | ((k & 4) << 1) | ((k & 8) >> 1); return ((kk >> 3) * 2 + (c >> 5)) * 512 + ((kk & 7) * 32 + (c & 31)) * 2; }
__device__ __forceinline__ int v_rd_base(int lane) { return ((lane & 3) << 3) | (((lane >> 2) & 3) << 6) | (((lane >> 4) & 1) << 5) | (((lane >> 5) & 1) << 8); }
constexpr int v_rd_off(int d0, int ks, int half) { return d0 * 512 + ks * 2048 + half * 1024; }
template <int OFF> __device__ __forceinline__ s16x4 tr_read(int vb) {
  s16x4 r; asm volatile("ds_read_b64_tr_b16 %0, %1 offset:%2" : "=&v"(r) : "v"(vb), "i"(OFF) : "memory"); return r;
}
template <int D0> __device__ __forceinline__ void pv_one(f32x16& od, int vb, bf16x8 pa0, bf16x8 pa1, bf16x8 pa2, bf16x8 pa3) {
  const s16x4 l0 = tr_read<v_rd_off(D0, 0, 0)>(vb), h0 = tr_read<v_rd_off(D0, 0, 1)>(vb), l1 = tr_read<v_rd_off(D0, 1, 0)>(vb), h1 = tr_read<v_rd_off(D0, 1, 1)>(vb);
  const s16x4 l2 = tr_read<v_rd_off(D0, 2, 0)>(vb), h2 = tr_read<v_rd_off(D0, 2, 1)>(vb), l3 = tr_read<v_rd_off(D0, 3, 0)>(vb), h3 = tr_read<v_rd_off(D0, 3, 1)>(vb);
  asm volatile("s_waitcnt lgkmcnt(0)" ::: "memory"); SBAR();
#define PK(L, H) (bf16x8){L[0], L[1], L[2], L[3], H[0], H[1], H[2], H[3]}
  od = __builtin_amdgcn_mfma_f32_32x32x16_bf16(pa0, PK(l0, h0), od, 0, 0, 0);
  od = __builtin_amdgcn_mfma_f32_32x32x16_bf16(pa1, PK(l1, h1), od, 0, 0, 0);
  od = __builtin_amdgcn_mfma_f32_32x32x16_bf16(pa2, PK(l2, h2), od, 0, 0, 0);
  od = __builtin_amdgcn_mfma_f32_32x32x16_bf16(pa3, PK(l3, h3), od, 0, 0, 0);
#undef PK
}
__device__ __forceinline__ void pv_d0(f32x16* o, int vb, bf16x8 pa0, bf16x8 pa1, bf16x8 pa2, bf16x8 pa3) {
  pv_one<0>(o[0], vb, pa0, pa1, pa2, pa3); pv_one<1>(o[1], vb, pa0, pa1, pa2, pa3);
}
__device__ __forceinline__ void maskfill(f32x16& p0, f32x16& p1) {
#pragma unroll
  for (int r = 0; r < 16; ++r) { p0[r] = -1e30f; p1[r] = -1e30f; }
}
__device__ __forceinline__ void attn_unit(int b, int h, int qb, const bf16_t* __restrict__ Q, const bf16_t* __restrict__ KN, const bf16_t* __restrict__ KPE,
                                          const bf16_t* __restrict__ V, bf16_t* __restrict__ AO, LAS char* lds, const int tid) {
  const int wid = tid >> 6, lane = tid & 63, r32 = lane & 31, hi = lane >> 5;
  LAS char* V_lds = lds + OFF_V; LAS char* K_lds = lds + OFF_K;
  LAS float* ws = (LAS float*)(lds + OFF_WS) + wid * 64; LAS float* li_l = ws; LAS float* al_l = ws + 32;
  const long rowbase = (long)b * SEQ; const int q0 = qb * 256;
  float m_reg = -1e30f, l_reg = 0; f32x16 o[2] = {}; bf16x8 qr[6];
  const bf16_t* Qw = Q + (rowbase + q0 + wid * QBLK + r32) * 768 + h * 96 + hi * 8;
#pragma unroll
  for (int d0 = 0; d0 < 6; ++d0) qr[d0] = *(const bf16x8*)(Qw + d0 * 16);
  const int sr = tid >> 3, sc = (tid & 7) * 8, srp = (tid >> 2) & 63, scp = (tid & 3) * 8;
  const bool hasp = tid < 256;
  const int vst0 = v_st(sr, sc);
  const int vb0 = (int)(unsigned)(uintptr_t)V_lds + v_rd_base(lane);
  const bf16_t* Kg = KN + rowbase * 512 + h * 64 + (long)sr * 512 + sc;
  const bf16_t* Vg = V + rowbase * 512 + h * 64 + (long)sr * 512 + sc;
  const bf16_t* Pg = KPE + rowbase * 32 + (long)srp * 32 + scp;
  bf16x8 vs0, ks0, kp0 = {};
#define SLOAD(k0) do { vs0 = *(const bf16x8*)(Vg + (long)(k0) * 512); ks0 = *(const bf16x8*)(Kg + (long)(k0) * 512); if (hasp) kp0 = *(const bf16x8*)(Pg + (long)(k0) * 32); } while (0)
#define SWRITE(bb) do { *(LAS bf16x8*)(V_lds + (bb) * SHM_V + vst0) = vs0; *(LAS bf16x8*)(K_lds + (bb) * SHM_K + KSWZ(sr, sc * 2)) = ks0; \
    if (hasp) *(LAS bf16x8*)(K_lds + (bb) * SHM_K + KSWZ(srp, (64 + scp) * 2)) = kp0; } while (0)
#define SWAIT() asm volatile("s_waitcnt vmcnt(0)" ::: "memory")
#define RESC(a) do { if (__any((a) < 1.f)) { if (hi == 0) al_l[r32] = (a); asm volatile("s_waitcnt lgkmcnt(0)" ::: "memory"); \
    _Pragma("unroll") for (int d = 0; d < 2; ++d) _Pragma("unroll") for (int r = 0; r < 16; ++r) o[d][r] *= al_l[crow(r, hi)]; } } while (0)
  const int NT = q0 / KVBLK + 4; const int vis = q0 / KVBLK + (wid >> 1);
#define MASK(P0, P1, t) do { if ((t) > vis) maskfill(P0, P1); } while (0)
  f32x16 pA0, pA1, pB0, pB1; float mnA, mnB, alA, alB; bf16x8 pa0, pa1, pa2, pa3;
  SLOAD(0); SWAIT(); SWRITE(0); __syncthreads();
  qkt(pA0, pA1, K_lds, qr, r32, hi); partialSM(pA0, pA1, m_reg, mnA, alA);
  SLOAD(KVBLK);
  SWAIT(); SWRITE(1); __syncthreads();
  for (int j = 1; j + 1 < NT; j += 2) {
    SBAR(); qkt(pB0, pB1, K_lds + SHM_K, qr, r32, hi); MASK(pB0, pB1, j);
    finishSM(pA0, pA1, alA, l_reg, pa0, pa1, pa2, pa3); SBAR();
    SLOAD((j + 1) * KVBLK); SBAR();
    pv_d0(o, vb0, pa0, pa1, pa2, pa3); partialSM(pB0, pB1, m_reg, mnB, alB);
    __syncthreads(); SWAIT(); SWRITE(0);
    RESC(alB); __syncthreads();
    SBAR(); qkt(pA0, pA1, K_lds, qr, r32, hi); MASK(pA0, pA1, j + 1);
    finishSM(pB0, pB1, alB, l_reg, pa0, pa1, pa2, pa3); SBAR();
    SLOAD((j + 2) * KVBLK); SBAR();
    pv_d0(o, vb0 + SHM_V, pa0, pa1, pa2, pa3); partialSM(pA0, pA1, m_reg, mnA, alA);
    __syncthreads(); SWAIT(); SWRITE(1);
    RESC(alA); __syncthreads();
  }
  SBAR(); qkt(pB0, pB1, K_lds + SHM_K, qr, r32, hi); MASK(pB0, pB1, NT - 1);
  finishSM(pA0, pA1, alA, l_reg, pa0, pa1, pa2, pa3); SBAR();
  pv_d0(o, vb0, pa0, pa1, pa2, pa3); partialSM(pB0, pB1, m_reg, mnB, alB);
  __syncthreads(); RESC(alB);
  finishSM(pB0, pB1, alB, l_reg, pa0, pa1, pa2, pa3); SBAR();
  pv_d0(o, vb0 + SHM_V, pa0, pa1, pa2, pa3);
  if (hi == 0) li_l[r32] = l_reg; asm volatile("s_waitcnt lgkmcnt(0)" ::: "memory");
  float rli[16];
#pragma unroll
  for (int r = 0; r < 16; ++r) rli[r] = __builtin_amdgcn_rcpf(li_l[crow(r, hi)]);
  bf16_t* Ow = AO + (rowbase + q0 + wid * QBLK) * 512 + h * 64;
#pragma unroll
  for (int r = 0; r < 16; ++r) { const int orow = crow(r, hi);
#pragma unroll
    for (int d0 = 0; d0 < 2; ++d0) Ow[(long)orow * 512 + d0 * 32 + r32] = (bf16_t)(cvtpk(o[d0][r] * rli[r], 0.f) & 0xffffu); }
  __syncthreads();
#undef SLOAD
#undef SWRITE
#undef SWAIT
#undef RESC
#undef MASK
}
#undef SBAR
}

struct Args {
    const float* x; const float* c; const int* pos; const float* ada_w; const float* ada_b; const float* norm1_g; const float* w_in; const float* lb_logits;
    const float* hg_norm_g; const float* q_norm_g; const float* w_q_up; const float* kv_norm_g; const float* w_kv_up; const float* w_br_a; const float* w_br_b;
    const float* w_out; const float* norm2_g; const float* w_router; const float* router_bias; const float* w_gate; const float* w_up; const float* w_down; const float* final_g;
    float* out; unsigned char* ws; int ph_lo, ph_hi;
};

__device__ __forceinline__ void tr_item(const float* src, int srcN, int sn0, bf16_t* dst, int dK, int dr0, int k0, const float* rs, bool il, bool zero, LAS float* scr, int lane) {
    if (!zero) {
#pragma unroll 8
        for (int i = 0; i < 32; ++i) { const int kk = 2 * i + (lane >> 5); float v = src[(size_t)(k0 + kk) * srcN + sn0 + (lane & 31)]; if (rs) v *= rs[k0 + kk]; scr[kk * 33 + (lane & 31)] = v; }
    }
    LDS_WAIT(); asm volatile("" ::: "memory");
    const int c = lane & 7;
#pragma unroll
    for (int j = 0; j < 4; ++j) {
        const int n = (lane >> 3) + 8 * j; const int sn = il ? ((n & 1) ? 16 + (n >> 1) : (n >> 1)) : n;
        const LAS float* s = scr + (8 * c) * 33 + sn;
        u32x4 o;
        if (zero) o = (u32x4){0u, 0u, 0u, 0u};
        else { o.x = cvt_pk_bf16(s[0 * 33], s[1 * 33]); o.y = cvt_pk_bf16(s[2 * 33], s[3 * 33]); o.z = cvt_pk_bf16(s[4 * 33], s[5 * 33]); o.w = cvt_pk_bf16(s[6 * 33], s[7 * 33]); }
        *(u32x4*)(dst + (size_t)(dr0 + n) * dK + k0 + 8 * c) = o;
    }
    LDS_WAIT(); asm volatile("" ::: "memory");
}
__device__ __forceinline__ void conv_weights(const Args& a, int l, LAS unsigned char* lds, int gw, int NGW, int wave, int lane) {
    LAS float* scr = (LAS float*)(lds + wave * 16384);
    bf16_t* WT = (bf16_t*)(a.ws + WS_WT);
    constexpr int I_IN = 16 * 152, I_QU = 6 * 24, I_KV = 4 * 32, I_BR = 8 * 32, I_OUT = 16 * 32, I_GU = NE * 16 * 32, I_DN = NE * 8 * 32;
    constexpr int NIT = I_IN + I_QU + I_KV + 2 * I_BR + I_OUT + I_GU + I_DN;
    for (int it = gw; it < NIT; it += NGW) {
        int r = it;
        if (r < I_IN) { const int kb = r / 152, db = r % 152; int sn0; bool il = false, zero = false;
            if (db < 64) sn0 = 32 * db; else if (db < 128) sn0 = 2720 + 32 * (db - 64); else if (db < 136) sn0 = 2432 + 32 * (db - 128); else if (db < 148) sn0 = 2048 + 32 * (db - 136);
            else if (db == 148) { sn0 = 2688; il = true; } else { sn0 = 0; zero = true; }
            tr_item(a.w_in + (size_t)l * 1024 * INCOLS, INCOLS, sn0, WT + WT_IN / 2, 1024, 32 * db, 64 * kb, nullptr, il, zero, scr, lane); continue; }
        r -= I_IN;
        if (r < I_QU) { const int kb = r / 24, db = r % 24;
            tr_item(a.w_q_up + (size_t)l * 384 * 768, 768, 32 * db, WT + WT_QU / 2, 384, 32 * db, 64 * kb, a.q_norm_g + l * 384, (db % 3) == 2, false, scr, lane); continue; }
        r -= I_QU;
        if (r < I_KV) { const int kb = r / 32, db = r % 32; const int hh = (db & 15) >> 1, half = db & 1; const int sn0 = hh * 128 + (db >= 16 ? 64 : 0) + 32 * half;
            tr_item(a.w_kv_up + (size_t)l * 256 * 1024, 1024, sn0, WT + WT_KV / 2, 256, 32 * db, 64 * kb, a.kv_norm_g + l * 256, false, false, scr, lane); continue; }
        r -= I_KV;
        if (r < I_BR) { const int kb = r / 32, db = r % 32; tr_item(a.w_br_a + (size_t)l * 512 * 1024, 1024, 32 * db, WT + WT_BA / 2, 512, 32 * db, 64 * kb, nullptr, false, false, scr, lane); continue; }
        r -= I_BR;
        if (r < I_BR) { const int kb = r / 32, db = r % 32; tr_item(a.w_br_b + (size_t)l * 512 * 1024, 1024, 32 * db, WT + WT_BB / 2, 512, 32 * db, 64 * kb, nullptr, false, false, scr, lane); continue; }
        r -= I_BR;
        if (r < I_OUT) { const int kb = r / 32, db = r % 32; tr_item(a.w_out + (size_t)l * 1024 * 1024, 1024, 32 * db, WT + WT_OUT / 2, 1024, 32 * db, 64 * kb, nullptr, false, false, scr, lane); continue; }
        r -= I_OUT;
        if (r < I_GU) { const int e = r / 512, q = r % 512, kb = q / 32, db = q % 32; const int pn = db >> 3, rr = db & 7;
            const float* src = (rr < 4 ? a.w_gate : a.w_up) + ((size_t)l * NE + e) * 1024 * 512;
            tr_item(src, 512, 128 * pn + 32 * (rr & 3), WT + WT_GU / 2 + (size_t)e * 1024 * 1024, 1024, 32 * db, 64 * kb, nullptr, false, false, scr, lane); continue; }
        r -= I_GU;
        { const int e = r / 256, q = r % 256, kb = q / 32, db = q % 32;
            tr_item(a.w_down + ((size_t)l * NE + e) * 512 * 1024, 1024, 32 * db, WT + WT_DN / 2 + (size_t)e * 1024 * 512, 512, 32 * db, 64 * kb, nullptr, false, false, scr, lane); }
    }
}
__device__ __forceinline__ void mod_phase(const Args& a, LAS unsigned char* lds, int tid, int wave, int lane) {
    LAS float* ca = (LAS float*)lds;
    LAS float* red = (LAS float*)(lds + 16384);
    float* mod = (float*)(a.ws + WS_MOD);
    for (int i = tid; i < 4096; i += NTHR) ca[i] = fsilu(a.c[i]);
    __syncthreads();
    for (int u = blockIdx.x; u < 192; u += gridDim.x) {
        const int l = u / 96, n0 = (u % 96) * 64;
        const float* W = a.ada_w + (size_t)l * 1024 * 6144 + n0 + lane;
        float s0 = 0.f, s1 = 0.f, s2 = 0.f, s3 = 0.f;
        const int kb = wave * 128;
#pragma unroll 8
        for (int k = 0; k < 128; ++k) { const float w = W[(size_t)(kb + k) * 6144]; s0 += ca[kb + k] * w; s1 += ca[1024 + kb + k] * w; s2 += ca[2048 + kb + k] * w; s3 += ca[3072 + kb + k] * w; }
        red[(wave * 4 + 0) * 64 + lane] = s0; red[(wave * 4 + 1) * 64 + lane] = s1; red[(wave * 4 + 2) * 64 + lane] = s2; red[(wave * 4 + 3) * 64 + lane] = s3;
        __syncthreads();
        if (tid < 256) { const int b = tid >> 6, col = tid & 63; float s = a.ada_b[l * 6144 + n0 + col];
#pragma unroll
            for (int w = 0; w < 8; ++w) s += red[(w * 4 + b) * 64 + col];
            mod[((size_t)l * 4 + b) * 6144 + n0 + col] = s; }
        __syncthreads();
    }
}
__device__ __forceinline__ void rope_phase(const Args& a, int gtid, int ngt) {
    f32x2* rope = (f32x2*)(a.ws + WS_ROPE);
    for (int i = gtid; i < T * 16; i += ngt) {
        const int t = i >> 4, k = i & 15;
        const double inv = exp(-(double)k * (9.210340371976184 / 16.0));
        const double ang = (double)a.pos[t] * inv;
        const double n = rint(ang * 0.15915494309189535);
        double r = fma(-n, 6.283185307179586, ang); r = fma(-n, 2.4492935982947064e-16, r);
        rope[i] = (f32x2){(float)cos(r), (float)sin(r)};
    }
}
__device__ __forceinline__ void norm_row(const float* xrow, bf16_t* orow, const float* g, const float* sc, const float* sh, int lane, f32x4 (&hv)[4]) {
    const f32x4* xr = (const f32x4*)xrow + lane;
    f32x4 v[4]; float s = 0.f;
#pragma unroll
    for (int j = 0; j < 4; ++j) { v[j] = xr[64 * j]; s += (v[j].x * v[j].x + v[j].y * v[j].y) + (v[j].z * v[j].z + v[j].w * v[j].w); }
    const float rstd = __builtin_amdgcn_rsqf(wave_sum(s) * (1.f / 1024.f) + EPS);
    u32x2* o8 = (u32x2*)orow + lane;
#pragma unroll
    for (int j = 0; j < 4; ++j) {
        const f32x4 gg = ((const f32x4*)g)[lane + 64 * j], cc = ((const f32x4*)sc)[lane + 64 * j], hh = ((const f32x4*)sh)[lane + 64 * j];
        f32x4 h = v[j] * rstd * gg * (cc + 1.f) + hh; hv[j] = h;
        u32x2 w; w.x = cvt_pk_bf16(h.x, h.y); w.y = cvt_pk_bf16(h.z, h.w); o8[64 * j] = w;
    }
}

constexpr int H1_BF = 0, H1_QT = 33792, H1_KT = H1_QT + 17408, H1_VT = H1_KT + 17408, H1_KD = H1_VT + 18432, H1_AT = H1_KD + 18432, H1_SEG = H1_AT + 9216, H1_END = H1_SEG + 2048;
static_assert(H1_END <= LDS_SCR_BYTES, "H1 LDS");
__device__ __forceinline__ void h1_unit(int u, bf16_t* QH, const bf16_t* LF, bf16_t* VH, bf16_t* UT, float* AC, LAS unsigned char* lds, int tid, int wave, int lane) {
    LAS float* Bf = (LAS float*)(lds + H1_BF);
    LAS bf16_t* Qt = (LAS bf16_t*)(lds + H1_QT);
    LAS bf16_t* Kt = (LAS bf16_t*)(lds + H1_KT);
    LAS bf16_t* VT = (LAS bf16_t*)(lds + H1_VT);
    LAS bf16_t* KdT = (LAS bf16_t*)(lds + H1_KD);
    LAS bf16_t* At = (LAS bf16_t*)(lds + H1_AT);
    LAS float* seg = (LAS float*)(lds + H1_SEG);
    const int bh = u >> 6, c = u & 63, b = bh >> 2, h = bh & 3;
    const size_t rowbase = (size_t)b * SEQ + (size_t)c * 64; const int col0 = h * 128;
    u32x4 qv[2], lv[2], vv[2];
#pragma unroll
    for (int i = 0; i < 2; ++i) { const int ch = wave + 8 * i; const size_t o = (rowbase + lane) * 512 + col0 + ch * 8;
        qv[i] = *(const u32x4*)(QH + o); lv[i] = *(const u32x4*)(LF + o); vv[i] = *(const u32x4*)(VH + o); }
#pragma unroll
    for (int i = 0; i < 2; ++i) { const int ch = wave + 8 * i; f32x4 a0, a1; unpack8(lv[i], a0, a1);
        *(LAS f32x4*)(Bf + lane * 132 + ch * 8) = a0; *(LAS f32x4*)(Bf + lane * 132 + ch * 8 + 4) = a1; }
    __syncthreads();
    { const int d = tid & 127, sg = tid >> 7; float run = 0.f;
#pragma unroll
        for (int r = 0; r < 16; ++r) { run += Bf[(sg * 16 + r) * 132 + d]; Bf[(sg * 16 + r) * 132 + d] = run; }
        seg[sg * 128 + d] = run;
        __syncthreads();
        float off = 0.f;
#pragma unroll
        for (int s = 0; s < 3; ++s) off += (s < sg) ? seg[s * 128 + d] : 0.f;
        if (sg > 0) {
#pragma unroll
            for (int r = 0; r < 16; ++r) Bf[(sg * 16 + r) * 132 + d] += off;
        }
    }
    __syncthreads();
#pragma unroll
    for (int i = 0; i < 2; ++i) {
        const int ch = wave + 8 * i, s = lane;
        f32x4 q0, q1, l0, l1, bb0, bb1, bl0, bl1, bm0, bm1;
        unpack8(qv[i], q0, q1); unpack8(lv[i], l0, l1);
        bb0 = *(const LAS f32x4*)(Bf + s * 132 + ch * 8); bb1 = *(const LAS f32x4*)(Bf + s * 132 + ch * 8 + 4);
        bl0 = *(const LAS f32x4*)(Bf + 63 * 132 + ch * 8); bl1 = *(const LAS f32x4*)(Bf + 63 * 132 + ch * 8 + 4);
        bm0 = *(const LAS f32x4*)(Bf + 31 * 132 + ch * 8); bm1 = *(const LAS f32x4*)(Bf + 31 * 132 + ch * 8 + 4);
        f32x4 qt0, qt1, kt0, kt1, kd0, kd1, qh0, qh1;
#pragma unroll
        for (int j = 0; j < 4; ++j) {
            const float k0 = 1.f - fexp(l0[j]), k1 = 1.f - fexp(l1[j]);
            qt0[j] = q0[j] * fexp(bb0[j] - bm0[j]); qt1[j] = q1[j] * fexp(bb1[j] - bm1[j]);
            kt0[j] = k0 * fexp(bm0[j] - bb0[j]); kt1[j] = k1 * fexp(bm1[j] - bb1[j]);
            kd0[j] = k0 * fexp(bl0[j] - bb0[j]); kd1[j] = k1 * fexp(bl1[j] - bb1[j]);
            qh0[j] = q0[j] * fexp(bb0[j]); qh1[j] = q1[j] * fexp(bb1[j]);
        }
        *(LAS u32x4*)(Qt + s * 136 + ch * 8) = pack8(qt0, qt1);
        *(LAS u32x4*)(Kt + s * 136 + ch * 8) = pack8(kt0, kt1);
        const u32x4 kdp = pack8(kd0, kd1);
#pragma unroll
        for (int j = 0; j < 4; ++j) {
            const unsigned kx = (unsigned)__shfl_xor((int)kdp[j], 1), vx = (unsigned)__shfl_xor((int)vv[i][j], 1);
            const bool odd = (s & 1) != 0; const int se = s & ~1;
            const unsigned kw = odd ? ((kx >> 16) | (kdp[j] & 0xffff0000u)) : ((kdp[j] & 0xffffu) | (kx << 16));
            const unsigned vw = odd ? ((vx >> 16) | (vv[i][j] & 0xffff0000u)) : ((vv[i][j] & 0xffffu) | (vx << 16));
            *(LAS unsigned*)(KdT + (ch * 8 + 2 * j + (odd ? 1 : 0)) * 72 + se) = kw;
            *(LAS unsigned*)(VT + (ch * 8 + 2 * j + (odd ? 1 : 0)) * 72 + se) = vw;
        }
        *(u32x4*)(QH + (rowbase + s) * 512 + col0 + ch * 8) = pack8(qh0, qh1);
        if (s == 63) { float* ac = AC + (size_t)u * 128 + ch * 8;
#pragma unroll
            for (int j = 0; j < 4; ++j) { ac[j] = fexp(bl0[j]); ac[4 + j] = fexp(bl1[j]); } }
    }
    __syncthreads();
    const int l15 = lane & 15, lq = lane >> 4;
    { const int tr = wave >> 1;
#pragma unroll
        for (int tci = 0; tci < 2; ++tci) { const int tc = (wave & 1) * 2 + tci; f32x4 acc = {0.f, 0.f, 0.f, 0.f};
            if (tc <= tr) {
#pragma unroll
                for (int ks = 0; ks < 4; ++ks) { const bf16x8 af = *(const LAS bf16x8*)(Qt + (16 * tr + l15) * 136 + 32 * ks + 8 * lq), bf = *(const LAS bf16x8*)(Kt + (16 * tc + l15) * 136 + 32 * ks + 8 * lq);
                    acc = __builtin_amdgcn_mfma_f32_16x16x32_bf16(af, bf, acc, 0, 0, 0); }
            }
#pragma unroll
            for (int r = 0; r < 4; ++r) { const int t = 16 * tr + 4 * lq + r, s = 16 * tc + l15; const float v = (s <= t) ? acc[r] : 0.f; const float vn = __shfl_xor(v, 1);
                if ((l15 & 1) == 0) *(LAS unsigned*)(At + t * 72 + s) = cvt_pk_bf16(v, vn); } }
    }
    __syncthreads();
    { const int vt = wave;
        bf16x8 af[2];
#pragma unroll
        for (int ks = 0; ks < 2; ++ks) af[ks] = *(const LAS bf16x8*)(VT + (16 * vt + l15) * 72 + 32 * ks + 8 * lq);
#pragma unroll
        for (int tt = 0; tt < 4; ++tt) { f32x4 acc = {0.f, 0.f, 0.f, 0.f};
#pragma unroll
            for (int ks = 0; ks < 2; ++ks) { const bf16x8 bf = *(const LAS bf16x8*)(At + (16 * tt + l15) * 72 + 32 * ks + 8 * lq); acc = __builtin_amdgcn_mfma_f32_16x16x32_bf16(af[ks], bf, acc, 0, 0, 0); }
            u32x2 w; w.x = cvt_pk_bf16(acc[0], acc[1]); w.y = cvt_pk_bf16(acc[2], acc[3]);
            *(u32x2*)(VH + (rowbase + 16 * tt + l15) * 512 + col0 + 16 * vt + 4 * lq) = w; }
    }
    { const int dt = wave;
        bf16x8 af[2];
#pragma unroll
        for (int ks = 0; ks < 2; ++ks) af[ks] = *(const LAS bf16x8*)(KdT + (16 * dt + l15) * 72 + 32 * ks + 8 * lq);
#pragma unroll
        for (int vt = 0; vt < 8; ++vt) { f32x4 acc = {0.f, 0.f, 0.f, 0.f};
#pragma unroll
            for (int ks = 0; ks < 2; ++ks) { const bf16x8 bf = *(const LAS bf16x8*)(VT + (16 * vt + l15) * 72 + 32 * ks + 8 * lq); acc = __builtin_amdgcn_mfma_f32_16x16x32_bf16(af[ks], bf, acc, 0, 0, 0); }
            u32x2 w; w.x = cvt_pk_bf16(acc[0], acc[1]); w.y = cvt_pk_bf16(acc[2], acc[3]);
            *(u32x2*)(UT + ((size_t)u * 128 + 16 * vt + l15) * 128 + 16 * dt + 4 * lq) = w; }
    }
    __syncthreads();
}
__device__ __forceinline__ void h2_scan(bf16_t* UT, const float* AC, int tid) {
    if (tid >= 256) return;
    for (int w = blockIdx.x * 256 + tid; w < 16 * 128 * 32; w += gridDim.x * 256) {
        const int bh = w >> 12, rem = w & 4095, v = rem >> 5, dq = rem & 31;
        bf16_t* p = UT + ((size_t)bh * 64 * 128 + v) * 128 + 4 * dq;
        const float* ap = AC + (size_t)bh * 64 * 128 + 4 * dq;
        f32x4 S = {0.f, 0.f, 0.f, 0.f};
        for (int c0 = 0; c0 < 64; c0 += 8) {
            u32x2 uu[8]; f32x4 aa[8];
#pragma unroll
            for (int k = 0; k < 8; ++k) { uu[k] = *(const u32x2*)(p + (size_t)(c0 + k) * 16384); aa[k] = *(const f32x4*)(ap + (size_t)(c0 + k) * 128); }
#pragma unroll
            for (int k = 0; k < 8; ++k) {
                u32x2 w2; w2.x = cvt_pk_bf16(S.x, S.y); w2.y = cvt_pk_bf16(S.z, S.w);
                *(u32x2*)(p + (size_t)(c0 + k) * 16384) = w2;
                const f32x4 uf = {bflo(uu[k].x), bfhi(uu[k].x), bflo(uu[k].y), bfhi(uu[k].y)};
                S = aa[k] * S + uf;
            }
        }
    }
}
__device__ __forceinline__ void h3_tile(int u, int tt, const bf16_t* QH, const bf16_t* VH, const bf16_t* HG, const bf16_t* UT, const float* gn, bf16_t* OA, int lane) {
    const int bh = u >> 6, c = u & 63, b = bh >> 2, h = bh & 3;
    const size_t row = (size_t)b * SEQ + (size_t)c * 64 + 16 * tt + (lane & 15); const int col0 = h * 128;
    const int l15 = lane & 15, lq = lane >> 4;
    bf16x8 bq[4];
#pragma unroll
    for (int ks = 0; ks < 4; ++ks) bq[ks] = *(const bf16x8*)(QH + row * 512 + col0 + 32 * ks + 8 * lq);
    f32x4 acc[8];
#pragma unroll
    for (int vt = 0; vt < 8; ++vt) { acc[vt] = (f32x4){0.f, 0.f, 0.f, 0.f};
#pragma unroll
        for (int ks = 0; ks < 4; ++ks) { const bf16x8 af = *(const bf16x8*)(UT + ((size_t)u * 128 + 16 * vt + l15) * 128 + 32 * ks + 8 * lq);
            acc[vt] = __builtin_amdgcn_mfma_f32_16x16x32_bf16(af, bq[ks], acc[vt], 0, 0, 0); } }
    float ss = 0.f;
#pragma unroll
    for (int vt = 0; vt < 8; ++vt) { const u32x2 iw = *(const u32x2*)(VH + row * 512 + col0 + 16 * vt + 4 * lq);
        acc[vt].x += bflo(iw.x); acc[vt].y += bfhi(iw.x); acc[vt].z += bflo(iw.y); acc[vt].w += bfhi(iw.y);
        ss += (acc[vt].x * acc[vt].x + acc[vt].y * acc[vt].y) + (acc[vt].z * acc[vt].z + acc[vt].w * acc[vt].w); }
    ss += __shfl_xor(ss, 16); ss += __shfl_xor(ss, 32);
    const float rstd = __builtin_amdgcn_rsqf(ss * (1.f / 128.f) + EPS);
#pragma unroll
    for (int vt = 0; vt < 8; ++vt) { const int cc = col0 + 16 * vt + 4 * lq;
        const f32x4 g = *(const f32x4*)(gn + cc); const u32x2 gw = *(const u32x2*)(HG + row * 512 + cc);
        const f32x4 o = acc[vt] * rstd * g * (f32x4){bflo(gw.x), bfhi(gw.x), bflo(gw.y), bfhi(gw.y)};
        u32x2 w; w.x = cvt_pk_bf16(o.x, o.y); w.y = cvt_pk_bf16(o.z, o.w);
        *(u32x2*)(OA + row * 512 + cc) = w; }
}

__device__ __forceinline__ Args load_args() {
#if defined(__HIP_DEVICE_COMPILE__)
    const __attribute__((address_space(4))) Args* ap = (const __attribute__((address_space(4))) Args*)__builtin_amdgcn_kernarg_segment_ptr();
    asm volatile("" : "+s"(ap));
    return *ap;
#else
    return Args{};
#endif
}
#define FRESH() int tid = tid0; asm volatile("" : "+v"(tid)); \
    const Args a = load_args(); \
    unsigned char* ws = a.ws; float* xo = a.out; \
    const int lane = tid & 63; const int wave = __builtin_amdgcn_readfirstlane(tid >> 6); const int gw = bx * NWAVES + wave; (void)lane; (void)wave; (void)gw; (void)xo
#define WSP(Tp, off) ((Tp*)(ws + (off)))
__global__ void __launch_bounds__(NTHR, 2) fwd(Args kargs) {
    extern __shared__ __attribute__((aligned(16))) unsigned char lds_raw[];
    LAS unsigned char* lds = (LAS unsigned char*)lds_raw;
    const int tid0 = threadIdx.x;
    const int G = gridDim.x, bx = blockIdx.x;
    const int NGW = G * NWAVES;
    unsigned* ctl = (unsigned*)(kargs.ws + WS_CTL);
    volatile LAS unsigned* MISC = (volatile LAS unsigned*)(lds + LDS_MISC);
    LAS int* UL = (LAS int*)(lds + LDS_MISC + 64);
    LAS int* NUN = (LAS int*)(lds + LDS_MISC + 512);
    LAS int* TCUM = (LAS int*)(lds + LDS_MISC + 576);
    for (int i = tid0; i < 1024; i += NTHR) ((LAS unsigned*)(lds + LDS_MISC))[i] = 0u;
    __syncthreads();
    XcdBarrier bar; bar.bar = ctl + CW_BAR; bar.x = 0; bar.st = nullptr;
    if (!MK_PER_PHASE) bar = xcd_barrier_post(ctl + CW_BAR, MISC);
    const int lo = kargs.ph_lo, hi = kargs.ph_hi;
#define IN(k) (lo <= (k) && (k) < hi)
#define SEAM(k) do { if (IN(k) && IN((k) + 1)) { if (MK_PER_PHASE) { if (tid0 == 0) __hip_atomic_store(ctl + CW_BAR + XB_TMO, 0xBADu, __ATOMIC_RELAXED, __HIP_MEMORY_SCOPE_AGENT); } else xcd_barrier(bar); } } while (0)

    if (PHEN(0) && IN(0)) {
        FRESH();
        mod_phase(a, lds, tid, wave, lane);
        rope_phase(a, bx * NTHR + tid, G * NTHR);
        if (bx == G - 1) { float* lbv = WSP(float, WS_LB); for (int j = tid; j < 512; j += NTHR) { lbv[j] = 0.f; lbv[512 + j] = fsigmoid(a.lb_logits[512 + j] - a.lb_logits[j]); } }
        conv_weights(a, 0, lds, gw, NGW, wave, lane);
    }
    SEAM(0);
    if (PHEN(1) && IN(1)) {
        FRESH();
        const float* mod = WSP(float, WS_MOD); bf16_t* HN = WSP(bf16_t, WS_HN);
        for (int m = gw; m < T; m += NGW) { const float* mb = mod + (size_t)(m >> 12) * 6144; f32x4 hv[4];
            norm_row(a.x + (size_t)m * 1024, HN + (size_t)m * 1024, a.norm1_g, mb + 1024, mb, lane, hv); }
    }
    SEAM(1);
    int ph = 2;
    for (int l = 0; l < DEPTH; ++l) {
        if (PHEN(2) && IN(ph)) {
            FRESH();
            pg8::ProbDense P; P.A = (const char*)WSP(bf16_t, WS_HN); P.Bt = (const char*)WSP(bf16_t, WS_WT + WT_IN); P.lda = 1024; P.ldb = 1024; P.K = 1024; P.S.init(T, NPROJ, G, bx);
            pg8::EpiProj E{WSP(bf16_t, WS_P + P_QH), WSP(bf16_t, WS_P + P_LF), WSP(bf16_t, WS_P + P_VH), WSP(bf16_t, WS_P + P_HG), WSP(bf16_t, WS_P + P_GT), WSP(bf16_t, WS_P + P_CKV),
                           WSP(bf16_t, WS_P + P_CQ), WSP(bf16_t, WS_P + P_KPE), WSP(float, WS_SSQKV), WSP(float, WS_SSQQ), WSP(float, WS_LB) + l * 512, WSP(const f32x2, WS_ROPE)};
            pg8::gemm_phase(lds, P, E, tid);
        }
        SEAM(ph); ++ph;
        if (PHEN(3) && IN(ph)) {
            if (!DBG_NOUP) { FRESH(); pg8::ProbDense P; P.A = (const char*)WSP(bf16_t, WS_P + P_CQ); P.Bt = (const char*)WSP(bf16_t, WS_WT + WT_QU); P.lda = 512; P.ldb = 384; P.K = 384; P.S.init(T, 768, G, bx);
              pg8::EpiQup E{WSP(bf16_t, WS_Q), WSP(float, WS_SSQQ), WSP(const f32x2, WS_ROPE)}; pg8::gemm_phase(lds, P, E, tid); }
            if (!DBG_NOUP) { FRESH(); pg8::ProbDense P; P.A = (const char*)WSP(bf16_t, WS_P + P_CKV); P.Bt = (const char*)WSP(bf16_t, WS_WT + WT_KV); P.lda = 256; P.ldb = 256; P.K = 256; P.S.init(T, 1024, G, (bx + 192) % G);
              pg8::EpiKVup E{WSP(bf16_t, WS_KN), WSP(bf16_t, WS_V), WSP(float, WS_SSQKV)}; pg8::gemm_phase(lds, P, E, tid); }
            __syncthreads();
            { FRESH();
              for (int u = bx; u < 1024; u += G) h1_unit(u, WSP(bf16_t, WS_P + P_QH), WSP(bf16_t, WS_P + P_LF), WSP(bf16_t, WS_P + P_VH), WSP(bf16_t, WS_UT), WSP(float, WS_AC), lds, tid, wave, lane); }
        }
        SEAM(ph); ++ph;
        if (PHEN(4) && IN(ph)) { FRESH(); h2_scan(WSP(bf16_t, WS_UT), WSP(float, WS_AC), tid); }
        SEAM(ph); ++ph;
        if (PHEN(5) && IN(ph)) {
            { FRESH();
              for (int p = bx; p < 256; p += G) { const int bh = p >> 3, s = p & 7;
                att::attn_unit(bh >> 3, bh & 7, 15 - s, WSP(bf16_t, WS_Q), WSP(bf16_t, WS_KN), WSP(bf16_t, WS_P + P_KPE), WSP(bf16_t, WS_V), WSP(bf16_t, WS_AO), (LAS char*)lds, tid);
                att::attn_unit(bh >> 3, bh & 7, s, WSP(bf16_t, WS_Q), WSP(bf16_t, WS_KN), WSP(bf16_t, WS_P + P_KPE), WSP(bf16_t, WS_V), WSP(bf16_t, WS_AO), (LAS char*)lds, tid); } }
            { FRESH();
              for (int w = gw; w < 4096; w += NGW) h3_tile(w >> 2, w & 3, WSP(bf16_t, WS_P + P_QH), WSP(bf16_t, WS_P + P_VH), WSP(bf16_t, WS_P + P_HG), WSP(bf16_t, WS_UT), a.hg_norm_g + l * 512, WSP(bf16_t, WS_OA), lane); }
        }
        SEAM(ph); ++ph;
        if (PHEN(6) && IN(ph)) {
            { FRESH(); pg8::ProbDense P; P.A = (const char*)WSP(bf16_t, WS_OA); P.Bt = (const char*)WSP(bf16_t, WS_WT + WT_BA); P.lda = 512; P.ldb = 512; P.K = 512; P.S.init(T, 1024, G, bx);
              pg8::EpiBr1 E{WSP(bf16_t, WS_TMP), WSP(bf16_t, WS_P + P_GT)}; pg8::gemm_phase(lds, P, E, tid); }
            VM_WAIT(); __syncthreads();
            { FRESH(); pg8::ProbDense P; P.A = (const char*)WSP(bf16_t, WS_AO); P.Bt = (const char*)WSP(bf16_t, WS_WT + WT_BB); P.lda = 512; P.ldb = 512; P.K = 512; P.S.init(T, 1024, G, bx);
              pg8::EpiBr2 E{WSP(bf16_t, WS_MG), WSP(bf16_t, WS_TMP), WSP(bf16_t, WS_P + P_GT)}; pg8::gemm_phase(lds, P, E, tid); }
        }
        SEAM(ph); ++ph;
        if (PHEN(7) && IN(ph)) {
            FRESH();
            pg8::ProbDense P; P.A = (const char*)WSP(bf16_t, WS_MG); P.Bt = (const char*)WSP(bf16_t, WS_WT + WT_OUT); P.lda = 1024; P.ldb = 1024; P.K = 1024; P.S.init(T, 1024, G, bx);
            pg8::EpiOut E{(l == 0) ? a.x : (const float*)xo, xo, WSP(float, WS_MOD) + (size_t)l * 4 * 6144 + 2048}; pg8::gemm_phase(lds, P, E, tid);
        }
        SEAM(ph); ++ph;
        if (PHEN(8) && IN(ph)) {
            FRESH();
            const float* modl = WSP(float, WS_MOD) + (size_t)l * 4 * 6144; bf16_t* HN = WSP(bf16_t, WS_HN);
            int* TL = WSP(int, WS_TL); float* WL = WSP(float, WS_WL); int* TS = WSP(int, WS_TS);
            LAS float* wrT = (LAS float*)lds;
            LAS int* lcnt = (LAS int*)(lds + 16 * 1028 * 4);
            LAS int* rec = lcnt + 64;
            for (int i = tid; i < 16384; i += NTHR) wrT[(i & 15) * 1028 + (i >> 4)] = a.w_router[i];
            if (tid < 32) lcnt[tid] = 0;
            __syncthreads();
            const int RPW = T / G;
            for (int rl = wave; rl < RPW; rl += NWAVES) {
                const int m = bx * RPW + rl; const float* mb = modl + (size_t)(m >> 12) * 6144; f32x4 hv[4];
                norm_row(xo + (size_t)m * 1024, HN + (size_t)m * 1024, a.norm2_g + l * 1024, mb + 4 * 1024, mb + 3 * 1024, lane, hv);
                float v[16];
#pragma unroll
                for (int e = 0; e < 16; ++e) { float s = 0.f;
#pragma unroll
                    for (int j = 0; j < 4; ++j) { const f32x4 w = *(const LAS f32x4*)(wrT + e * 1028 + 4 * lane + 256 * j); s += (hv[j].x * w.x + hv[j].y * w.y) + (hv[j].z * w.z + hv[j].w * w.w); }
                    v[e] = s; }
                { const bool b5 = (lane & 32) != 0;
#pragma unroll
                  for (int i = 0; i < 8; ++i) { const float own = b5 ? v[i + 8] : v[i], snd = b5 ? v[i] : v[i + 8]; v[i] = own + __shfl_xor(snd, 32); }
                  const bool b4 = (lane & 16) != 0;
#pragma unroll
                  for (int i = 0; i < 4; ++i) { const float own = b4 ? v[i + 4] : v[i], snd = b4 ? v[i] : v[i + 4]; v[i] = own + __shfl_xor(snd, 16); }
                  const bool b3 = (lane & 8) != 0;
#pragma unroll
                  for (int i = 0; i < 2; ++i) { const float own = b3 ? v[i + 2] : v[i], snd = b3 ? v[i] : v[i + 2]; v[i] = own + __shfl_xor(snd, 8); }
                  const bool b2 = (lane & 4) != 0;
                  { const float own = b2 ? v[1] : v[0], snd = b2 ? v[0] : v[1]; v[0] = own + __shfl_xor(snd, 4); }
                  v[0] += __shfl_xor(v[0], 2); v[0] += __shfl_xor(v[0], 1); }
                float sc[16], bz[16];
#pragma unroll
                for (int e = 0; e < 16; ++e) { const int src = ((e >> 3) & 1) * 32 + ((e >> 2) & 1) * 16 + ((e >> 1) & 1) * 8 + (e & 1) * 4;
                    const float lg = __uint_as_float(__builtin_amdgcn_readlane(__float_as_uint(v[0]), src)); sc[e] = fsigmoid(lg); bz[e] = sc[e] + a.router_bias[e]; }
                float gs[4];
#pragma unroll
                for (int g = 0; g < 4; ++g) { const float p = bz[4 * g], q = bz[4 * g + 1], r = bz[4 * g + 2], s = bz[4 * g + 3];
                    const float h1 = fmaxf(p, q), l1 = fminf(p, q), h2 = fmaxf(r, s), l2 = fminf(r, s);
                    gs[g] = fmaxf(h1, h2) + fmaxf(fminf(h1, h2), fmaxf(l1, l2)); }
                int gi = 0; float gb = gs[0];
#pragma unroll
                for (int g = 1; g < 4; ++g) if (gs[g] > gb) { gb = gs[g]; gi = g; }
                float c0 = bz[0], c1 = bz[1], c2 = bz[2], c3 = bz[3], t0 = sc[0], t1 = sc[1], t2 = sc[2], t3 = sc[3];
#pragma unroll
                for (int g = 1; g < 4; ++g) if (gi == g) { c0 = bz[4 * g]; c1 = bz[4 * g + 1]; c2 = bz[4 * g + 2]; c3 = bz[4 * g + 3]; t0 = sc[4 * g]; t1 = sc[4 * g + 1]; t2 = sc[4 * g + 2]; t3 = sc[4 * g + 3]; }
                int i1 = 0; float b1 = c0, s1 = t0;
                if (c1 > b1) { b1 = c1; i1 = 1; s1 = t1; } if (c2 > b1) { b1 = c2; i1 = 2; s1 = t2; } if (c3 > b1) { b1 = c3; i1 = 3; s1 = t3; }
                int i2 = -1; float b2v = -INFINITY, s2 = 0.f;
                if (i1 != 0 && c0 > b2v) { b2v = c0; i2 = 0; s2 = t0; } if (i1 != 1 && c1 > b2v) { b2v = c1; i2 = 1; s2 = t1; }
                if (i1 != 2 && c2 > b2v) { b2v = c2; i2 = 2; s2 = t2; } if (i1 != 3 && c3 > b2v) { b2v = c3; i2 = 3; s2 = t3; }
                if (i2 < 0) { i2 = (i1 == 0) ? 1 : 0; s2 = (i1 == 0) ? t1 : t0; }
                const int e1 = 4 * gi + i1, e2 = 4 * gi + i2; const float inv = 1.f / (s1 + s2);
                if (lane == 0) { const int p1 = atomicAdd((int*)(lcnt + e1), 1), p2 = atomicAdd((int*)(lcnt + e2), 1);
                    LAS int* rc = rec + rl * 8; rc[0] = e1; rc[1] = e2; rc[2] = p1; rc[3] = p2; rc[4] = __float_as_int(s1 * inv); rc[5] = __float_as_int(s2 * inv); }
            }
            __syncthreads();
            if (tid < 16) lcnt[16 + tid] = (int)__hip_atomic_fetch_add(ctl + CW_CNT + (l * 16 + tid) * 64, (unsigned)lcnt[tid], __ATOMIC_RELAXED, __HIP_MEMORY_SCOPE_AGENT);
            __syncthreads();
            if (tid < RPW) { const LAS int* rc = rec + tid * 8; const int m = bx * RPW + tid; const int e1 = rc[0], e2 = rc[1]; const int p1 = lcnt[16 + e1] + rc[2], p2 = lcnt[16 + e2] + rc[3];
                TL[e1 * T + p1] = m; TL[e2 * T + p2] = m; WL[e1 * T + p1] = __int_as_float(rc[4]); WL[e2 * T + p2] = __int_as_float(rc[5]);
                TS[2 * m] = (e1 << 16) | p1; TS[2 * m + 1] = (e2 << 16) | p2; }
            __syncthreads();
        }
        SEAM(ph); ++ph;
#define MOE_SETUP() do { if (tid == 0) { int cum = 0; \
            _Pragma("unroll") for (int e = 0; e < 16; ++e) { const int cn = (int)__hip_atomic_load(ctl + CW_CNT + (l * 16 + e) * 64, __ATOMIC_RELAXED, __HIP_MEMORY_SCOPE_AGENT); TCUM[32 + e] = cn; TCUM[e] = cum; cum += (cn + 255) >> 8; } \
            TCUM[16] = cum; int n = 0; \
            for (int L = bx; L < cum * 4 && n < 8; L += G, ++n) { const int tile = L >> 2, pn = L & 3; int e = 0; \
                _Pragma("unroll") for (int k = 1; k < 16; ++k) if (tile >= TCUM[k]) e = k; \
                const int rt = tile - TCUM[e]; int nv = TCUM[32 + e] - rt * 256; nv = nv > 256 ? 256 : nv; \
                UL[n * 8 + 0] = tile; UL[n * 8 + 1] = pn; UL[n * 8 + 2] = e; UL[n * 8 + 3] = rt; UL[n * 8 + 4] = nv; } \
            NUN[0] = n; } \
        __syncthreads(); } while (0)
        if (PHEN(9) && IN(ph)) {
            FRESH();
            MOE_SETUP();
            const int nun = __builtin_amdgcn_readfirstlane(NUN[0]);
            pg8::ProbMoeGU P; P.A = (const char*)WSP(bf16_t, WS_HN); P.Bt = (const char*)WSP(bf16_t, WS_WT + WT_GU); P.TL = WSP(int, WS_TL); P.ul = UL; P.nun = nun; P.lda = 1024; P.ldb = 1024; P.K = 1024;
            pg8::EpiGU E{WSP(bf16_t, WS_HE)}; pg8::gemm_phase(lds, P, E, tid);
            __syncthreads();
        }
        SEAM(ph); ++ph;
        if (PHEN(11) && IN(ph)) {
            FRESH();
            MOE_SETUP();
            const int nun = __builtin_amdgcn_readfirstlane(NUN[0]);
            pg8::ProbMoeDown P; P.A = (const char*)WSP(bf16_t, WS_HE); P.Bt = (const char*)WSP(bf16_t, WS_WT + WT_DN); P.ul = UL; P.nun = nun; P.lda = 512; P.ldb = 512; P.K = 512;
            pg8::EpiDown E{WSP(bf16_t, WS_Y), WSP(float, WS_WL)}; pg8::gemm_phase(lds, P, E, tid);
            __syncthreads();
        }
        SEAM(ph); ++ph;
        if (PHEN(10) && IN(ph)) {
            FRESH();
            const float* mod = WSP(float, WS_MOD); const float* modl = mod + (size_t)l * 4 * 6144; bf16_t* HN = WSP(bf16_t, WS_HN); const bf16_t* Yb = WSP(bf16_t, WS_Y); const int* TS = WSP(int, WS_TS);
            if (tid == 0) { int cum = 0;
#pragma unroll
                for (int e = 0; e < 16; ++e) { const int cn = (int)__hip_atomic_load(ctl + CW_CNT + (l * 16 + e) * 64, __ATOMIC_RELAXED, __HIP_MEMORY_SCOPE_AGENT); TCUM[e] = cum; cum += (cn + 255) >> 8; } }
            __syncthreads();
            for (int m = gw; m < T; m += NGW) {
                const float* mb = modl + (size_t)(m >> 12) * 6144;
                const int t1 = TS[2 * m], t2 = TS[2 * m + 1];
                const size_t r1 = (size_t)TCUM[t1 >> 16] * 256 + (t1 & 0xffff), r2 = (size_t)TCUM[t2 >> 16] * 256 + (t2 & 0xffff);
                float* xr = xo + (size_t)m * 1024;
                f32x4 v[4]; float s = 0.f;
#pragma unroll
                for (int j = 0; j < 4; ++j) {
                    const f32x4 x0 = ((const f32x4*)xr)[lane + 64 * j]; const f32x4 g2 = ((const f32x4*)(mb + 5 * 1024))[lane + 64 * j];
                    const u32x2 y1 = ((const u32x2*)(Yb + r1 * 1024))[lane + 64 * j], y2 = ((const u32x2*)(Yb + r2 * 1024))[lane + 64 * j];
                    const f32x4 ys = (f32x4){bflo(y1.x) + bflo(y2.x), bfhi(y1.x) + bfhi(y2.x), bflo(y1.y) + bflo(y2.y), bfhi(y1.y) + bfhi(y2.y)};
                    v[j] = x0 + g2 * ys;
                    s += (v[j].x * v[j].x + v[j].y * v[j].y) + (v[j].z * v[j].z + v[j].w * v[j].w);
                }
                const float rstd = __builtin_amdgcn_rsqf(wave_sum(s) * (1.f / 1024.f) + EPS);
                if (l + 1 < DEPTH) {
                    const float* mn = mod + ((size_t)(l + 1) * 4 + (m >> 12)) * 6144;
                    u32x2* o8 = (u32x2*)(HN + (size_t)m * 1024) + lane;
#pragma unroll
                    for (int j = 0; j < 4; ++j) { ((f32x4*)xr)[lane + 64 * j] = v[j];
                        const f32x4 gg = ((const f32x4*)(a.norm1_g + (l + 1) * 1024))[lane + 64 * j], cc = ((const f32x4*)(mn + 1024))[lane + 64 * j], hh = ((const f32x4*)mn)[lane + 64 * j];
                        const f32x4 h = v[j] * rstd * gg * (cc + 1.f) + hh; u32x2 w; w.x = cvt_pk_bf16(h.x, h.y); w.y = cvt_pk_bf16(h.z, h.w); o8[64 * j] = w; }
                } else {
#pragma unroll
                    for (int j = 0; j < 4; ++j) { const f32x4 gg = ((const f32x4*)a.final_g)[lane + 64 * j]; ((f32x4*)xr)[lane + 64 * j] = v[j] * rstd * gg; }
                }
            }
            if (l + 1 < DEPTH) { __syncthreads(); conv_weights(a, l + 1, lds, gw, NGW, wave, lane); }
        }
        if (l + 1 < DEPTH) SEAM(ph);
        ++ph;
    }
#undef IN
#undef SEAM
}
constexpr int N_PHASES = 2 + DEPTH * 10;


#ifndef DBG_NAN
#define DBG_NAN 0
#endif
#if DBG_NAN
struct DbgReg { size_t off; size_t n; int f32; };
__global__ void dbg_scan(unsigned char* ws, const float* out) {
    const DbgReg regs[] = {
        {WS_MOD, 2 * 4 * 6144, 1}, {WS_LB, 1024, 1}, {WS_ROPE, (size_t)T * 32, 1}, {WS_SSQKV, (size_t)T * 8, 1}, {WS_SSQQ, (size_t)T * 16, 1}, {WS_AC, 1024 * 128, 1},
        {WS_WT, WT_END / 2, 0}, {WS_HN, (size_t)T * 1024, 0}, {WS_P + P_QH, (size_t)T * 512, 0}, {WS_P + P_LF, (size_t)T * 512, 0}, {WS_P + P_VH, (size_t)T * 512, 0},
        {WS_P + P_HG, (size_t)T * 512, 0}, {WS_P + P_GT, (size_t)T * 2048, 0}, {WS_P + P_CKV, (size_t)T * 256, 0}, {WS_P + P_CQ, (size_t)T * 512, 0}, {WS_P + P_KPE, (size_t)T * 32, 0},
        {WS_Q, (size_t)T * 768, 0}, {WS_KN, (size_t)T * 512, 0}, {WS_V, (size_t)T * 512, 0}, {WS_UT, (size_t)1024 * 128 * 128, 0}};
    unsigned* flags = (unsigned*)(ws + WS_CTL) + 8192;
    const size_t gt = (size_t)blockIdx.x * blockDim.x + threadIdx.x, ng = (size_t)gridDim.x * blockDim.x;
    for (int r = 0; r < 20; ++r) {
        bool bad = false;
        if (regs[r].f32) { const unsigned* p = (const unsigned*)(ws + regs[r].off); for (size_t i = gt; i < regs[r].n; i += ng) bad |= (p[i] & 0x7F800000u) == 0x7F800000u; }
        else { const unsigned short* p = (const unsigned short*)(ws + regs[r].off); for (size_t i = gt; i < regs[r].n; i += ng) bad |= (p[i] & 0x7F80u) == 0x7F80u; }
        if (bad) atomicOr(flags, 1u << r);
    }
    { bool bad = false; const unsigned* p = (const unsigned*)out; for (size_t i = gt; i < (size_t)T * 1024; i += ng) bad |= (p[i] & 0x7F800000u) == 0x7F800000u; if (bad) atomicOr(flags, 1u << 20); }
}
#ifndef DBG_REG
#define DBG_REG 19
#endif
#ifndef DBG_MODE
#define DBG_MODE 0
#endif
__global__ void dbg_stat(unsigned char* ws, size_t off, size_t n, int f32) {
    unsigned* st = (unsigned*)(ws + WS_CTL) + 8200;
    const size_t gt = (size_t)blockIdx.x * blockDim.x + threadIdx.x, ng = (size_t)gridDim.x * blockDim.x;
    unsigned mx = 0, cnt = 0;
    for (size_t i = gt; i < n; i += ng) { unsigned u = f32 ? ((const unsigned*)(ws + off))[i] : ((unsigned)((const unsigned short*)(ws + off))[i] << 16);
        if ((u & 0x7F800000u) == 0x7F800000u) ++cnt; else { u &= 0x7FFFFFFFu; mx = u > mx ? u : mx; } }
    atomicMax(st, mx); if (cnt) atomicAdd(st + 1, cnt);
}
__global__ void dbg_write2(unsigned char* ws, float* out) {
    const unsigned* st = (const unsigned*)(ws + WS_CTL) + 8200;
    const size_t gt = (size_t)blockIdx.x * blockDim.x + threadIdx.x, ng = (size_t)gridDim.x * blockDim.x;
    for (size_t i = gt; i < (size_t)T * 1024; i += ng) out[i] = 0.f;
    if (gt == 0) out[0] = DBG_MODE == 0 ? 1e3f * __uint_as_float(st[0]) : 1e3f + (float)st[1];
}
__global__ void dbg_write(unsigned char* ws, float* out) {
    const unsigned flags = ((const unsigned*)(ws + WS_CTL))[8192];
    const size_t gt = (size_t)blockIdx.x * blockDim.x + threadIdx.x, ng = (size_t)gridDim.x * blockDim.x;
    for (size_t i = gt; i < (size_t)T * 1024; i += ng) out[i] = 0.f;
    if (gt == 0) { float v = 500.f; if (flags) { v = 1000.f; for (int k = 0; k < __builtin_ctz(flags); ++k) v *= 2.f; } out[0] = v; }
}
#endif
extern "C" void kernel_launch(void* const* d_in, const int* in_sizes, int n_in, void* d_out, int out_size, void* d_ws, size_t ws_size, hipStream_t stream) {
    static int ok = 0;
    if (ok == 0) {
        if (n_in != 23 || in_sizes[0] != T * DM || out_size != T * DM || ws_size < WS_END) {
            fprintf(stderr, "kernel_launch: unexpected shapes: n_in %d in0 %d out %d ws %zu (need %zu)\n", n_in, n_in > 0 ? in_sizes[0] : -1, out_size, ws_size, (size_t)WS_END); ok = -1; return; }
        if (hipFuncSetAttribute((const void*)fwd, hipFuncAttributeMaxDynamicSharedMemorySize, LDS_BYTES) != hipSuccess) { fprintf(stderr, "kernel_launch: hipFuncSetAttribute failed\n"); ok = -1; return; }
        int per_cu = 0;
        if (hipOccupancyMaxActiveBlocksPerMultiprocessor(&per_cu, (const void*)fwd, NTHR, LDS_BYTES) != hipSuccess || per_cu < 1)
            fprintf(stderr, "kernel_launch: note: occupancy query reports %d workgroups per CU\n", per_cu);
        (void)hipGetLastError();
        ok = 1;
    }
    if (ok < 0) return;
    (void)hipMemsetAsync((char*)d_ws + WS_CTL, 0, CTL_BYTES, stream);
    Args a{};
    a.x = (const float*)d_in[0]; a.c = (const float*)d_in[1]; a.pos = (const int*)d_in[2]; a.ada_w = (const float*)d_in[3]; a.ada_b = (const float*)d_in[4];
    a.norm1_g = (const float*)d_in[5]; a.w_in = (const float*)d_in[6]; a.lb_logits = (const float*)d_in[7]; a.hg_norm_g = (const float*)d_in[8]; a.q_norm_g = (const float*)d_in[9];
    a.w_q_up = (const float*)d_in[10]; a.kv_norm_g = (const float*)d_in[11]; a.w_kv_up = (const float*)d_in[12]; a.w_br_a = (const float*)d_in[13]; a.w_br_b = (const float*)d_in[14];
    a.w_out = (const float*)d_in[15]; a.norm2_g = (const float*)d_in[16]; a.w_router = (const float*)d_in[17]; a.router_bias = (const float*)d_in[18];
    a.w_gate = (const float*)d_in[19]; a.w_up = (const float*)d_in[20]; a.w_down = (const float*)d_in[21]; a.final_g = (const float*)d_in[22];
    a.out = (float*)d_out; a.ws = (unsigned char*)d_ws;
    const int grid = 256;
#if MK_PER_PHASE
#ifndef MAXPH
#define MAXPH N_PHASES
#endif
    for (int p = 0; p < MAXPH; ++p) { a.ph_lo = p; a.ph_hi = p + 1; hipLaunchKernelGGL(fwd, dim3(grid), dim3(NTHR), LDS_BYTES, stream, a); }
#else
    a.ph_lo = 0; a.ph_hi = N_PHASES; hipLaunchKernelGGL(fwd, dim3(grid), dim3(NTHR), LDS_BYTES, stream, a);
#endif
#if DBG_NAN
    if (DBG_REG < 0) {
    hipLaunchKernelGGL(dbg_scan, dim3(1024), dim3(256), 0, stream, (unsigned char*)d_ws, (const float*)d_out);
    hipLaunchKernelGGL(dbg_write, dim3(1024), dim3(256), 0, stream, (unsigned char*)d_ws, (float*)d_out);
    } else {
    const DbgReg regs[] = {
        {WS_MOD, 2 * 4 * 6144, 1}, {WS_LB, 1024, 1}, {WS_ROPE, (size_t)T * 32, 1}, {WS_SSQKV, (size_t)T * 8, 1}, {WS_SSQQ, (size_t)T * 16, 1}, {WS_AC, 1024 * 128, 1},
        {WS_WT, WT_END / 2, 0}, {WS_HN, (size_t)T * 1024, 0}, {WS_P + P_QH, (size_t)T * 512, 0}, {WS_P + P_LF, (size_t)T * 512, 0}, {WS_P + P_VH, (size_t)T * 512, 0},
        {WS_P + P_HG, (size_t)T * 512, 0}, {WS_P + P_GT, (size_t)T * 2048, 0}, {WS_P + P_CKV, (size_t)T * 256, 0}, {WS_P + P_CQ, (size_t)T * 512, 0}, {WS_P + P_KPE, (size_t)T * 32, 0},
        {WS_Q, (size_t)T * 768, 0}, {WS_KN, (size_t)T * 512, 0}, {WS_V, (size_t)T * 512, 0}, {WS_UT, (size_t)1024 * 128 * 128, 0}};
    const int r = DBG_REG < 0 ? 0 : DBG_REG;
    hipLaunchKernelGGL(dbg_stat, dim3(1024), dim3(256), 0, stream, (unsigned char*)d_ws, regs[r].off, regs[r].n, regs[r].f32);
    hipLaunchKernelGGL(dbg_write2, dim3(1024), dim3(256), 0, stream, (unsigned char*)d_ws, (float*)d_out);
    }
#endif
    const hipError_t le = hipPeekAtLastError();
    if (le != hipSuccess) fprintf(stderr, "kernel_launch: launch failed: %s\n", hipGetErrorName(le));
}
```

```cpp
#include <hip/hip_runtime.h>
#include <cstdio>
#include <cstdint>

#define GAS __attribute__((address_space(1)))
#define LAS __attribute__((address_space(3)))
typedef unsigned short bf16_t;
typedef short bf16x8 __attribute__((ext_vector_type(8)));
typedef short s16x4 __attribute__((ext_vector_type(4)));
typedef float f32x2 __attribute__((ext_vector_type(2)));
typedef float f32x4 __attribute__((ext_vector_type(4)));
typedef float f32x16 __attribute__((ext_vector_type(16)));
typedef unsigned u32x2 __attribute__((ext_vector_type(2)));
typedef unsigned u32x4 __attribute__((ext_vector_type(4)));

#ifndef REP_MASK
#define REP_MASK 0
#endif
#define REPS(k) (1 + (((REP_MASK) >> (k)) & 1))
#ifndef DBG_NOUP
#define DBG_NOUP 0
#endif
#ifndef PH_MASK
#define PH_MASK 0xFFFF
#endif
#define PHEN(k) (((PH_MASK) >> (k)) & 1)
#ifndef MK_PER_PHASE
#define MK_PER_PHASE 0
#endif

constexpr int T = 16384, DM = 1024, NB = 4, SEQ = 4096, DEPTH = 2;
constexpr int NPROJ = 4864, INCOLS = 4768;
constexpr int NE = 16, DE = 512;
constexpr int SLOTROWS = 2 * T + 4096;
constexpr int NWAVES = 8, NTHR = 512;
constexpr float EPS = 1e-6f;

constexpr size_t WS_CTL = 0, CTL_BYTES = 1u << 20;
constexpr size_t WS_MOD = WS_CTL + CTL_BYTES;
constexpr size_t WS_LB = WS_MOD + 2 * 4 * 6144 * 4;
constexpr size_t WS_ROPE = WS_LB + 2 * 512 * 4;
constexpr size_t WS_SSQKV = WS_ROPE + (size_t)T * 16 * 8;
constexpr size_t WS_SSQQ = WS_SSQKV + (size_t)T * 8 * 4;
constexpr size_t WS_AC = WS_SSQQ + (size_t)T * 16 * 4;
constexpr size_t WS_TL = WS_AC + 1024 * 128 * 4;
constexpr size_t WS_WL = WS_TL + (size_t)NE * T * 4;
constexpr size_t WS_TS = WS_WL + (size_t)NE * T * 4;
constexpr size_t WS_WT = WS_TS + (size_t)T * 2 * 4;
constexpr size_t WT_IN = 0, WT_QU = WT_IN + (size_t)NPROJ * 1024 * 2, WT_KV = WT_QU + 768 * 384 * 2, WT_BA = WT_KV + 1024 * 256 * 2,
                 WT_BB = WT_BA + 1024 * 512 * 2, WT_OUT = WT_BB + 1024 * 512 * 2, WT_GU = WT_OUT + 1024 * 1024 * 2,
                 WT_DN = WT_GU + (size_t)NE * 1024 * 1024 * 2, WT_END = WT_DN + (size_t)NE * 1024 * 512 * 2;
constexpr size_t WS_HN = WS_WT + WT_END;
constexpr size_t WS_P = WS_HN + (size_t)T * 1024 * 2;
constexpr size_t P_QH = 0, P_LF = P_QH + (size_t)T * 512 * 2, P_VH = P_LF + (size_t)T * 512 * 2, P_HG = P_VH + (size_t)T * 512 * 2,
                 P_GT = P_HG + (size_t)T * 512 * 2, P_CKV = P_GT + (size_t)T * 2048 * 2, P_CQ = P_CKV + (size_t)T * 256 * 2,
                 P_KPE = P_CQ + (size_t)T * 512 * 2, P_END = P_KPE + (size_t)T * 32 * 2;
constexpr size_t WS_Q = WS_P + P_END;
constexpr size_t WS_KN = WS_Q + (size_t)T * 768 * 2;
constexpr size_t WS_V = WS_KN + (size_t)T * 512 * 2;
constexpr size_t WS_UT = WS_V + (size_t)T * 512 * 2;
constexpr size_t WS_END = WS_UT + (size_t)1024 * 128 * 128 * 2;
constexpr size_t WS_AO = WS_P + P_CQ;
constexpr size_t WS_OA = WS_P + P_LF;
constexpr size_t WS_MG = WS_Q;
constexpr size_t WS_TMP = WS_UT;
constexpr size_t WS_HE = WS_P;
constexpr size_t WS_Y = WS_HE + (size_t)SLOTROWS * 512 * 2;
static_assert(WS_Y + (size_t)SLOTROWS * 1024 * 2 <= WS_P + P_END, "MoE overlay fits the projection set");
static_assert((size_t)T * 1024 * 2 <= (size_t)T * 768 * 2 + (size_t)T * 512 * 2, "MG fits Q|KN");
static_assert(WS_END <= 379290688ull, "workspace map exceeds sum(inputs)");
constexpr int CW_BAR = 4096;
constexpr int CW_CNT = 16384;

constexpr int LDS_SCR = 0, LDS_SCR_BYTES = 131072, LDS_MISC = 131072, LDS_BYTES = 147456;

typedef __bf16 bf16x2_t __attribute__((ext_vector_type(2)));
__device__ __forceinline__ unsigned cvt_pk_bf16(float lo, float hi) { f32x2 v = {lo, hi}; bf16x2_t b = __builtin_convertvector(v, bf16x2_t); return __builtin_bit_cast(unsigned, b); }
__device__ __forceinline__ float bf2f(unsigned short h) { return __uint_as_float((unsigned)h << 16); }
__device__ __forceinline__ float bflo(unsigned w) { return __uint_as_float(w << 16); }
__device__ __forceinline__ float bfhi(unsigned w) { return __uint_as_float(w & 0xffff0000u); }
__device__ __forceinline__ float fexp(float x) { return __builtin_amdgcn_exp2f(x * 1.4426950408889634f); }
__device__ __forceinline__ float fsigmoid(float x) { return __builtin_amdgcn_rcpf(1.f + fexp(-x)); }
__device__ __forceinline__ float fsilu(float x) { return x * fsigmoid(x); }
__device__ __forceinline__ float flog(float x) { return __builtin_amdgcn_logf(x) * 0.6931471805599453f; }
__device__ __forceinline__ u32x4 pack8(f32x4 a, f32x4 b) { u32x4 w; w.x = cvt_pk_bf16(a.x, a.y); w.y = cvt_pk_bf16(a.z, a.w); w.z = cvt_pk_bf16(b.x, b.y); w.w = cvt_pk_bf16(b.z, b.w); return w; }
__device__ __forceinline__ void unpack8(u32x4 w, f32x4& a, f32x4& b) { a.x = bflo(w.x); a.y = bfhi(w.x); a.z = bflo(w.y); a.w = bfhi(w.y); b.x = bflo(w.z); b.y = bfhi(w.z); b.z = bflo(w.w); b.w = bfhi(w.w); }
__device__ __forceinline__ float wave_sum(float v) {
#pragma unroll
    for (int o = 1; o < 64; o <<= 1) v += __shfl_xor(v, o);
    return v;
}
#define LDS_WAIT() asm volatile("s_waitcnt lgkmcnt(0)" ::: "memory")
#define VM_WAIT() asm volatile("s_waitcnt vmcnt(0)" ::: "memory")

#define XB_TMO      128
#define XB_XCNT(j)  (256  + 64 * (j))
#define XB_XSUB(j)  (1280 + 64 * (j))
#define XB_XGEN(j)  (2304 + 64 * (j))
#define XB_TOP      3328
#define XB_TOPGEN   3392
#define XCD_BAR_WORDS 3456
#define XB_SPIN_CAP (1u << 18)
__device__ __forceinline__ unsigned xb_ld(unsigned* p)              { return __hip_atomic_load(p, __ATOMIC_RELAXED, __HIP_MEMORY_SCOPE_AGENT); }
__device__ __forceinline__ unsigned xb_add(unsigned* p, unsigned v) { return __hip_atomic_fetch_add(p, v, __ATOMIC_RELAXED, __HIP_MEMORY_SCOPE_AGENT); }
__device__ __forceinline__ unsigned xb_xcc_id() { return (unsigned)__builtin_amdgcn_s_getreg((3 << 11) | 20) & 0xFu; }
#define XB_SPIN(cond, bar) do { unsigned _sp = 0; while (cond) { __builtin_amdgcn_s_sleep(1); \
    if ((++_sp & 255u) == 0u) { if (xb_ld(&(bar)[XB_TMO])) break; if (_sp > XB_SPIN_CAP) { atomicAdd(&(bar)[XB_TMO], 1u); break; } } } } while (0)
struct XcdBarrier { unsigned* bar; unsigned x; volatile LAS unsigned* st; };
__device__ __forceinline__ XcdBarrier xcd_barrier_post(unsigned* bar, volatile LAS unsigned* st) {
    XcdBarrier b; b.bar = bar; b.x = xb_xcc_id(); b.st = st;
    if (threadIdx.x == 0) (void)xb_add(&bar[XB_XCNT(b.x)], 1u);
    return b;
}
__device__ __forceinline__ void xcd_barrier_complete(unsigned* bar, unsigned x, unsigned& nloc, unsigned& nx) {
    const unsigned G = gridDim.x * gridDim.y * gridDim.z;
    unsigned sum, cnt, mine, sp = 0u;
    for (;;) {
        sum = 0u; cnt = 0u; mine = 0u;
#pragma unroll
        for (unsigned j = 0; j < 16; ++j) { const unsigned c = xb_ld(&bar[XB_XCNT(j)]); sum += c; cnt += (c > 0u) ? 1u : 0u; mine = (j == x) ? c : mine; }
        if (sum == G) break;
        __builtin_amdgcn_s_sleep(1);
        if ((++sp & 255u) == 0u) { if (xb_ld(&bar[XB_TMO])) break; if (sp > XB_SPIN_CAP) { atomicAdd(&bar[XB_TMO], 1u); break; } }
    }
    nloc = mine > 0u ? mine : 1u; nx = cnt > 0u ? cnt : 1u;
}
__device__ __forceinline__ void xcd_barrier(const XcdBarrier& b) {
    asm volatile("s_waitcnt vmcnt(0)" ::: "memory");
    __syncthreads();
    if (threadIdx.x == 0) {
        unsigned* bar = b.bar;
        __builtin_amdgcn_s_waitcnt(0);
        unsigned nloc = b.st[0], nx = b.st[1];
        if (nloc == 0u) { xcd_barrier_complete(bar, b.x, nloc, nx); b.st[0] = nloc; b.st[1] = nx; }
        const unsigned old = xb_add(&bar[XB_XSUB(b.x)], 1u);
        const unsigned gen = old / nloc;
        if (old + 1u == (gen + 1u) * nloc) {
            __builtin_amdgcn_fence(__ATOMIC_RELEASE, "agent");
            asm volatile("s_waitcnt vmcnt(0)" ::: "memory");
            const unsigned og = xb_add(&bar[XB_TOP], 1u);
            const unsigned tg = og / nx;
            if (og + 1u == (tg + 1u) * nx) xb_add(&bar[XB_TOPGEN], 1u);
            else XB_SPIN(xb_ld(&bar[XB_TOPGEN]) == tg, bar);
            __builtin_amdgcn_fence(__ATOMIC_ACQUIRE, "agent");
            xb_add(&bar[XB_XGEN(b.x)], 1u);
            asm volatile("s_waitcnt vmcnt(0)" ::: "memory");
        } else {
            XB_SPIN(xb_ld(&bar[XB_XGEN(b.x)]) == gen, bar);
            __builtin_amdgcn_fence(__ATOMIC_ACQUIRE, "agent");
            asm volatile("s_waitcnt vmcnt(0)" ::: "memory");
        }
    }
    __syncthreads();
}

namespace pg8 {
constexpr int BM = 256, BK = 64, HALF = 128, HTB = HALF * BK * 2, STAGE_BYTES = 8 * HTB, NXCD = 8, WGM = 8;
__host__ __device__ __forceinline__ int lds_byte(int r, int c) { const int st = (r >> 4) * 2 + (c >> 5), rr = r & 15, cc = c & 31, ob = rr * 64 + cc * 2; return st * 1024 + (ob ^ (((ob >> 9) & 1) << 5)); }
__host__ __device__ __forceinline__ void stage_rc(int b, int& R, int& C) { const int st = b / 1024, sb = b % 1024, swz = sb ^ (((sb >> 9) & 1) << 5); R = (st >> 1) * 16 + swz / 64; C = (st & 1) * 32 + (swz % 64) / 2; }
__host__ __device__ __forceinline__ int perm32(int rho) { const int n = rho >> 4, i = rho & 15; return 8 * (i >> 2) + 4 * n + (i & 3); }

struct Unit { int pm, pn, e, rt, nv; };

struct StaticOrder {
    int nM, nN, nwg, G, c;
    __device__ __forceinline__ void init(int M, int N, int G_, int c_) { nM = M / BM; nN = N / BM; nwg = nM * nN; G = G_; c = c_; }
    __device__ __forceinline__ bool next(int i, Unit& u) const {
        const long L = (long)i * G + c; if (L >= nwg) return false;
        int wgid = (int)L; { const int q = nwg / NXCD, r = nwg % NXCD, xcd = wgid % NXCD, off = wgid / NXCD; wgid = (xcd < r ? xcd * (q + 1) : r * (q + 1) + (xcd - r) * q) + off; }
        const int nig = WGM * nN, gid = wgid / nig, fm = gid * WGM, gsz = (nM - fm) < WGM ? (nM - fm) : WGM;
        u.pm = fm + ((wgid % nig) % gsz); u.pn = (wgid % nig) / gsz; return true;
    }
};

template <class Epi, class Prob>
__device__ __forceinline__ void gemm_phase(LAS unsigned char* lds, const Prob& P, const Epi& E, const int tid) {
    const int wid = __builtin_amdgcn_readfirstlane(tid >> 6), lane = tid & 63, wr = wid >> 2, wc = wid & 3, fr = lane & 15, fq = lane >> 4;
    const int nt = P.K / BK;
    unsigned voffB[2];
#pragma unroll
    for (int i = 0; i < 2; ++i) { int R, C; stage_rc(tid * 16 + i * 8192, R, C); const int Rb = (R & ~31) + perm32(R & 31); voffB[i] = (unsigned)(Rb * P.ldb + C) * 2u; }
    const size_t kstep = (size_t)(BK * 2);
    const size_t hstepB = (size_t)HALF * P.ldb * 2;
    const unsigned ldsw = (unsigned)wid * 1024u;
    const int aoff = lds_byte(wr * 64 + fr, fq * 8), boff = lds_byte(wc * 32 + fr, fq * 8);
#define PG8_SA(b, h) (((b) * 2 + (h)) * HTB)
#define PG8_SB(b, h) ((4 + (b) * 2 + (h)) * HTB)
#define PG8_STAGE(bufoff, gbase, voff) do { _Pragma("unroll") for (int _i = 0; _i < 2; ++_i) \
        __builtin_amdgcn_global_load_lds((const unsigned*)((const char*)(gbase) + (voff)[_i]), (LAS unsigned*)(lds + (bufoff) + ldsw + _i * 8192), 16, 0, 0); } while (0)
#define PG8_LDA(dst, b, h) do { _Pragma("unroll") for (int m = 0; m < 4; ++m) _Pragma("unroll") for (int k = 0; k < 2; ++k) dst[m][k] = *(const LAS bf16x8*)(lds + PG8_SA(b, h) + aoff + m * 2048 + k * 1024); } while (0)
#define PG8_LDB(dst, b, h) do { _Pragma("unroll") for (int n = 0; n < 2; ++n) _Pragma("unroll") for (int k = 0; k < 2; ++k) dst[n][k] = *(const LAS bf16x8*)(lds + PG8_SB(b, h) + boff + n * 2048 + k * 1024); } while (0)
#define PG8_MMA(ai, bj, At, Bt) do { __builtin_amdgcn_s_setprio(1); _Pragma("unroll") for (int m = 0; m < 4; ++m) _Pragma("unroll") for (int n = 0; n < 2; ++n) _Pragma("unroll") for (int k = 0; k < 2; ++k) \
        acc[ai][bj][m][n] = __builtin_amdgcn_mfma_f32_16x16x32_bf16(Bt[n][k], At[m][k], acc[ai][bj][m][n], 0, 0, 0); __builtin_amdgcn_s_setprio(0); } while (0)
#define PG8_WAIT_V(n) asm volatile("s_waitcnt vmcnt(" #n ")" ::: "memory")
#define PG8_WAIT_L(n) asm volatile("s_waitcnt lgkmcnt(" #n ")" ::: "memory")
#define PG8_BAR __builtin_amdgcn_s_barrier()
#define PG8_SCHED __builtin_amdgcn_sched_barrier(0)
    Unit cur, nxt; int ui = 0;
    if (!P.next(0, cur)) return;
    f32x4 acc[2][2][4][2];
#pragma unroll
    for (int a = 0; a < 2; ++a)
#pragma unroll
        for (int b = 0; b < 2; ++b)
#pragma unroll
            for (int m = 0; m < 4; ++m)
#pragma unroll
                for (int n = 0; n < 2; ++n) acc[a][b][m][n] = (f32x4){0.f, 0.f, 0.f, 0.f};
    bf16x8 At[4][2], B0[2][2], B1[2][2];
    unsigned oc[2][2];
    P.a_off(cur, tid, oc);
    const char* const Ab = P.A;
    const char* cB = P.b_ptr(cur);
    PG8_STAGE(PG8_SB(0, 0), cB, voffB); PG8_STAGE(PG8_SB(0, 1), cB + hstepB, voffB); PG8_STAGE(PG8_SA(0, 0), Ab, oc[0]); PG8_STAGE(PG8_SA(0, 1), Ab, oc[1]);
    if (wr == 1) PG8_BAR;
    PG8_WAIT_V(2); PG8_BAR;
    PG8_STAGE(PG8_SB(1, 0), cB + kstep, voffB); PG8_STAGE(PG8_SA(1, 0), Ab + kstep, oc[0]); PG8_STAGE(PG8_SB(1, 1), cB + hstepB + kstep, voffB);
    PG8_WAIT_V(6); PG8_BAR;
    for (;;) {
        const bool has_next = P.next(ui + 1, nxt);
        const char* nB = has_next ? P.b_ptr(nxt) : cB;
        for (int t = 0; t < nt; t += 2) {
            const bool last = (t == nt - 2);
            const char* a1 = Ab + (size_t)(t + 1) * kstep;
            const char* a2 = last ? Ab : Ab + (size_t)(t + 2) * kstep; const char* b2 = last ? nB : cB + (size_t)(t + 2) * kstep;
            const char* a3 = a2 + kstep; const char* b3 = b2 + kstep;
            const char* b2h = b2 + hstepB; const char* b3h = b3 + hstepB;
            asm volatile("" : "+s"(a1), "+s"(a2), "+s"(a3));
            asm volatile("" : "+s"(b2), "+s"(b3), "+s"(b2h), "+s"(b3h));
            unsigned o2[2][2];
#pragma unroll
            for (int h = 0; h < 2; ++h)
#pragma unroll
                for (int i = 0; i < 2; ++i) o2[h][i] = oc[h][i];
            if (last && has_next) P.a_off(nxt, tid, o2);
            PG8_LDB(B0, 0, 0); PG8_LDB(B1, 0, 1); PG8_SCHED; PG8_LDA(At, 0, 0); PG8_STAGE(PG8_SA(1, 1), a1, oc[1]);
            PG8_WAIT_V(8); PG8_WAIT_L(0); PG8_BAR; PG8_MMA(0, 0, At, B0); PG8_MMA(0, 1, At, B1); PG8_BAR; PG8_SCHED;
            PG8_LDA(At, 0, 1); PG8_STAGE(PG8_SB(0, 0), b2, voffB); PG8_STAGE(PG8_SB(0, 1), b2h, voffB); PG8_STAGE(PG8_SA(0, 0), a2, o2[0]);
            PG8_WAIT_V(8); PG8_WAIT_L(0); PG8_BAR; PG8_MMA(1, 0, At, B0); PG8_MMA(1, 1, At, B1); PG8_BAR; PG8_SCHED;
            PG8_LDB(B0, 1, 0); PG8_LDB(B1, 1, 1); PG8_SCHED; PG8_LDA(At, 1, 0); PG8_STAGE(PG8_SA(0, 1), a2, o2[1]);
            PG8_WAIT_V(8); PG8_WAIT_L(0); PG8_BAR; PG8_MMA(0, 0, At, B0); PG8_MMA(0, 1, At, B1); PG8_BAR; PG8_SCHED;
            PG8_LDA(At, 1, 1); PG8_STAGE(PG8_SB(1, 0), b3, voffB); PG8_STAGE(PG8_SB(1, 1), b3h, voffB); PG8_STAGE(PG8_SA(1, 0), a3, o2[0]);
            PG8_WAIT_V(8); PG8_WAIT_L(0); PG8_BAR; PG8_MMA(1, 0, At, B0); PG8_MMA(1, 1, At, B1); PG8_BAR; PG8_SCHED;
        }
        if (wr == 0) PG8_BAR;
        E(acc, cur, wr, wc, fr, fq);
        if (!has_next) break;
#pragma unroll
        for (int a = 0; a < 2; ++a)
#pragma unroll
            for (int b = 0; b < 2; ++b)
#pragma unroll
                for (int m = 0; m < 4; ++m)
#pragma unroll
                    for (int n = 0; n < 2; ++n) acc[a][b][m][n] = (f32x4){0.f, 0.f, 0.f, 0.f};
        cur = nxt; cB = nB; ++ui;
        P.a_off(cur, tid, oc);
        if (wr == 1) PG8_BAR;
    }
    PG8_WAIT_V(0);
    PG8_BAR;
#undef PG8_SA
#undef PG8_SB
#undef PG8_STAGE
#undef PG8_LDA
#undef PG8_LDB
#undef PG8_MMA
#undef PG8_WAIT_V
#undef PG8_WAIT_L
#undef PG8_BAR
#undef PG8_SCHED
}

struct ProbDense {
    const char* A; const char* Bt; int lda, ldb, K; StaticOrder S;
    __device__ __forceinline__ bool next(int i, Unit& u) const { u.e = 0; u.rt = 0; u.nv = 256; return S.next(i, u); }
    __device__ __forceinline__ void a_off(const Unit& u, int tid, unsigned (&o)[2][2]) const {
#pragma unroll
        for (int i = 0; i < 2; ++i) { int R, C; stage_rc(tid * 16 + i * 8192, R, C);
#pragma unroll
            for (int h = 0; h < 2; ++h) o[h][i] = (unsigned)((u.pm * 256 + h * 128 + R) * lda + C) * 2u; }
    }
    __device__ __forceinline__ const char* b_ptr(const Unit& u) const { return Bt + (size_t)u.pn * 256 * ldb * 2; }
};
struct ProbMoeGU {
    const char* A; const char* Bt; const int* TL; const LAS int* ul; int nun; int lda, ldb, K;
    __device__ __forceinline__ bool next(int i, Unit& u) const { if (i >= nun) return false; const LAS int* p = ul + i * 8; u.pm = __builtin_amdgcn_readfirstlane(p[0]); u.pn = __builtin_amdgcn_readfirstlane(p[1]); u.e = __builtin_amdgcn_readfirstlane(p[2]); u.rt = __builtin_amdgcn_readfirstlane(p[3]); u.nv = __builtin_amdgcn_readfirstlane(p[4]); return true; }
    __device__ __forceinline__ void a_off(const Unit& u, int tid, unsigned (&o)[2][2]) const {
#pragma unroll
        for (int i = 0; i < 2; ++i) { int R, C; stage_rc(tid * 16 + i * 8192, R, C);
#pragma unroll
            for (int h = 0; h < 2; ++h) { const int idx = h * 128 + R; const int tok = idx < u.nv ? TL[u.e * T + u.rt * 256 + idx] : 0; o[h][i] = (unsigned)(tok * 1024 + C) * 2u; } }
    }
    __device__ __forceinline__ const char* b_ptr(const Unit& u) const { return Bt + ((size_t)u.e * 1024 + (size_t)u.pn * 256) * 1024 * 2; }
};
struct ProbMoeDown {
    const char* A; const char* Bt; const LAS int* ul; int nun; int lda, ldb, K;
    __device__ __forceinline__ bool next(int i, Unit& u) const { if (i >= nun) return false; const LAS int* p = ul + i * 8; u.pm = __builtin_amdgcn_readfirstlane(p[0]); u.pn = __builtin_amdgcn_readfirstlane(p[1]); u.e = __builtin_amdgcn_readfirstlane(p[2]); u.rt = __builtin_amdgcn_readfirstlane(p[3]); u.nv = __builtin_amdgcn_readfirstlane(p[4]); return true; }
    __device__ __forceinline__ void a_off(const Unit& u, int tid, unsigned (&o)[2][2]) const {
#pragma unroll
        for (int i = 0; i < 2; ++i) { int R, C; stage_rc(tid * 16 + i * 8192, R, C);
#pragma unroll
            for (int h = 0; h < 2; ++h) o[h][i] = (unsigned)((u.pm * 256 + h * 128 + R) * 512 + C) * 2u; }
    }
    __device__ __forceinline__ const char* b_ptr(const Unit& u) const { return Bt + ((size_t)u.e * 1024 + (size_t)u.pn * 256) * 512 * 2; }
};

#define EPI_ARGS const f32x4 (&acc)[2][2][4][2], const Unit& u, int wr, int wc, int fr, int fq
struct EpiProj {
    bf16_t *QH, *LF, *VH, *HG, *GT, *CKV, *CQ, *KPE; float *SSQKV, *SSQQ; const float* lb; const f32x2* rope;
    __device__ __forceinline__ void operator()(EPI_ARGS) const {
        const int pn = u.pn;
        bf16_t* ob; int ldc, coff, mode;
        if (pn < 8) { const int g = pn >> 1; ob = g == 0 ? QH : g == 1 ? LF : g == 2 ? VH : HG; ldc = 512; coff = (pn & 1) * 256; mode = g == 0 ? 0 : g == 1 ? 1 : g == 2 ? 2 : 3; }
        else if (pn < 16) { ob = GT; ldc = 2048; coff = (pn - 8) * 256; mode = 4; }
        else if (pn == 16) { ob = CKV; ldc = 256; coff = 0; mode = 2; }
        else { ob = CQ; ldc = 512; coff = (pn - 17) * 256; mode = 2; }
#pragma unroll
        for (int ai = 0; ai < 2; ++ai)
#pragma unroll
            for (int m = 0; m < 4; ++m) {
                const int row = u.pm * 256 + ai * 128 + wr * 64 + m * 16 + fr;
#pragma unroll
                for (int bj = 0; bj < 2; ++bj) {
                    const int lc = bj * 128 + wc * 32 + 8 * fq;
                    f32x4 v0 = acc[ai][bj][m][0], v1 = acc[ai][bj][m][1];
                    if (mode == 0) {
#pragma unroll
                        for (int j = 0; j < 4; ++j) { v0[j] = fsilu(v0[j]) * 0.08838834764831845f; v1[j] = fsilu(v1[j]) * 0.08838834764831845f; }
                    } else if (mode == 1) {
                        const f32x4 l0 = *(const f32x4*)(lb + coff + lc), l1 = *(const f32x4*)(lb + coff + lc + 4);
#pragma unroll
                        for (int j = 0; j < 4; ++j) { v0[j] = flog(l0[j] + (1.f - l0[j]) * fsigmoid(v0[j])); v1[j] = flog(l1[j] + (1.f - l1[j]) * fsigmoid(v1[j])); }
                    } else if (mode == 3) {
#pragma unroll
                        for (int j = 0; j < 4; ++j) { v0[j] = fsilu(v0[j]); v1[j] = fsilu(v1[j]); }
                    } else if (mode == 4) {
#pragma unroll
                        for (int j = 0; j < 4; ++j) { v0[j] = fsigmoid(v0[j]); v1[j] = fsigmoid(v1[j]); }
                    }
                    *(u32x4*)(ob + (size_t)row * ldc + coff + lc) = pack8(v0, v1);
                    if (pn >= 16) {
                        float ss = 0.f;
#pragma unroll
                        for (int j = 0; j < 4; ++j) ss += v0[j] * v0[j] + v1[j] * v1[j];
                        ss += __shfl_xor(ss, 16); ss += __shfl_xor(ss, 32);
                        if (fq == 0) {
                            if (pn == 16) SSQKV[(size_t)row * 8 + bj * 4 + wc] = ss;
                            else SSQQ[(size_t)row * 16 + ((pn - 17) * 2 + bj) * 4 + wc] = ss;
                        }
                        if (pn == 18 && bj == 1 && wc == 0) {
                            const f32x2* rp = rope + (size_t)row * 16 + 4 * fq;
                            const f32x2 c0 = rp[0], c1 = rp[1], c2 = rp[2], c3 = rp[3];
                            f32x4 r0, r1;
                            r0.x = v0.x * c0.x - v0.y * c0.y; r0.y = v0.x * c0.y + v0.y * c0.x; r0.z = v0.z * c1.x - v0.w * c1.y; r0.w = v0.z * c1.y + v0.w * c1.x;
                            r1.x = v1.x * c2.x - v1.y * c2.y; r1.y = v1.x * c2.y + v1.y * c2.x; r1.z = v1.z * c3.x - v1.w * c3.y; r1.w = v1.z * c3.y + v1.w * c3.x;
                            *(u32x4*)(KPE + (size_t)row * 32 + 8 * fq) = pack8(r0, r1);
                        }
                    }
                    asm volatile("" ::: "memory");
                }
            }
    }
};
struct EpiQup {
    bf16_t* Q; const float* SSQQ; const f32x2* rope;
    __device__ __forceinline__ void operator()(EPI_ARGS) const {
#pragma unroll
        for (int ai = 0; ai < 2; ++ai)
#pragma unroll
            for (int m = 0; m < 4; ++m) {
                const int row = u.pm * 256 + ai * 128 + wr * 64 + m * 16 + fr;
                const f32x4 s0 = *(const f32x4*)(SSQQ + (size_t)row * 16), s1 = *(const f32x4*)(SSQQ + (size_t)row * 16 + 4), s2 = *(const f32x4*)(SSQQ + (size_t)row * 16 + 8);
                const float ss = ((s0.x + s0.y) + (s0.z + s0.w)) + ((s1.x + s1.y) + (s1.z + s1.w)) + ((s2.x + s2.y) + (s2.z + s2.w));
                const float rstd = __builtin_amdgcn_rsqf(ss * (1.f / 384.f) + EPS);
#pragma unroll
                for (int bj = 0; bj < 2; ++bj) {
                    const int lc = bj * 128 + wc * 32 + 8 * fq;
                    const int g = u.pn * 8 + bj * 4 + wc;
                    f32x4 v0 = acc[ai][bj][m][0] * rstd, v1 = acc[ai][bj][m][1] * rstd;
                    if (g % 3 == 2) {
                        const f32x2* rp = rope + (size_t)row * 16 + 4 * fq;
                        const f32x2 c0 = rp[0], c1 = rp[1], c2 = rp[2], c3 = rp[3];
                        f32x4 r0, r1;
                        r0.x = v0.x * c0.x - v0.y * c0.y; r0.y = v0.x * c0.y + v0.y * c0.x; r0.z = v0.z * c1.x - v0.w * c1.y; r0.w = v0.z * c1.y + v0.w * c1.x;
                        r1.x = v1.x * c2.x - v1.y * c2.y; r1.y = v1.x * c2.y + v1.y * c2.x; r1.z = v1.z * c3.x - v1.w * c3.y; r1.w = v1.z * c3.y + v1.w * c3.x;
                        v0 = r0; v1 = r1;
                    }
                    *(u32x4*)(Q + (size_t)row * 768 + u.pn * 256 + lc) = pack8(v0, v1);
                    asm volatile("" ::: "memory");
                }
            }
    }
};
struct EpiKVup {
    bf16_t *KN, *V; const float* SSQKV;
    __device__ __forceinline__ void operator()(EPI_ARGS) const {
        bf16_t* ob = u.pn < 2 ? KN : V; const int coff = (u.pn & 1) * 256;
#pragma unroll
        for (int ai = 0; ai < 2; ++ai)
#pragma unroll
            for (int m = 0; m < 4; ++m) {
                const int row = u.pm * 256 + ai * 128 + wr * 64 + m * 16 + fr;
                const f32x4 s0 = *(const f32x4*)(SSQKV + (size_t)row * 8), s1 = *(const f32x4*)(SSQKV + (size_t)row * 8 + 4);
                const float ss = ((s0.x + s0.y) + (s0.z + s0.w)) + ((s1.x + s1.y) + (s1.z + s1.w));
                const float rstd = __builtin_amdgcn_rsqf(ss * (1.f / 256.f) + EPS);
#pragma unroll
                for (int bj = 0; bj < 2; ++bj) {
                    const int lc = bj * 128 + wc * 32 + 8 * fq;
                    *(u32x4*)(ob + (size_t)row * 512 + coff + lc) = pack8(acc[ai][bj][m][0] * rstd, acc[ai][bj][m][1] * rstd);
                }
                asm volatile("" ::: "memory");
            }
    }
};
struct EpiBr1 {
    bf16_t* O; const bf16_t* GT;
    __device__ __forceinline__ void operator()(EPI_ARGS) const {
#pragma unroll
        for (int ai = 0; ai < 2; ++ai)
#pragma unroll
            for (int m = 0; m < 4; ++m) {
                const int row = u.pm * 256 + ai * 128 + wr * 64 + m * 16 + fr;
#pragma unroll
                for (int bj = 0; bj < 2; ++bj) {
                    const int col = u.pn * 256 + bj * 128 + wc * 32 + 8 * fq;
                    f32x4 g0, g1; unpack8(*(const u32x4*)(GT + (size_t)row * 2048 + col), g0, g1);
                    *(u32x4*)(O + (size_t)row * 1024 + col) = pack8(acc[ai][bj][m][0] * g0, acc[ai][bj][m][1] * g1);
                }
                asm volatile("" ::: "memory");
            }
    }
};
struct EpiBr2 {
    bf16_t* O; const bf16_t* TMP; const bf16_t* GT;
    __device__ __forceinline__ void operator()(EPI_ARGS) const {
#pragma unroll
        for (int ai = 0; ai < 2; ++ai)
#pragma unroll
            for (int m = 0; m < 4; ++m) {
                const int row = u.pm * 256 + ai * 128 + wr * 64 + m * 16 + fr;
#pragma unroll
                for (int bj = 0; bj < 2; ++bj) {
                    const int col = u.pn * 256 + bj * 128 + wc * 32 + 8 * fq;
                    f32x4 g0, g1, t0, t1; unpack8(*(const u32x4*)(GT + (size_t)row * 2048 + 1024 + col), g0, g1); unpack8(*(const u32x4*)(TMP + (size_t)row * 1024 + col), t0, t1);
                    *(u32x4*)(O + (size_t)row * 1024 + col) = pack8(t0 + acc[ai][bj][m][0] * g0, t1 + acc[ai][bj][m][1] * g1);
                    asm volatile("" ::: "memory");
                }
            }
    }
};
struct EpiOut {
    const float* xin; float* xout; const float* g1; int dry;
    __device__ __forceinline__ void operator()(EPI_ARGS) const {
#pragma unroll
        for (int ai = 0; ai < 2; ++ai)
#pragma unroll
            for (int m = 0; m < 4; ++m) {
                const int row = u.pm * 256 + ai * 128 + wr * 64 + m * 16 + fr;
                const float* gp = g1 + (size_t)(row >> 12) * 6144;
#pragma unroll
                for (int bj = 0; bj < 2; ++bj) {
                    const int col = u.pn * 256 + bj * 128 + wc * 32 + 8 * fq;
                    const size_t o = (size_t)row * 1024 + col;
                    const f32x4 x0 = *(const f32x4*)(xin + o), x1 = *(const f32x4*)(xin + o + 4);
                    const f32x4 ga = *(const f32x4*)(gp + col), gb = *(const f32x4*)(gp + col + 4);
                    if (!dry) { *(f32x4*)(xout + o) = x0 + ga * acc[ai][bj][m][0];
                    *(f32x4*)(xout + o + 4) = x1 + gb * acc[ai][bj][m][1]; }
                    asm volatile("" ::: "memory");
                }
            }
    }
};
struct EpiGU {
    bf16_t* HE;
    __device__ __forceinline__ void operator()(EPI_ARGS) const {
#pragma unroll
        for (int ai = 0; ai < 2; ++ai)
#pragma unroll
            for (int m = 0; m < 4; ++m) {
                const int row = u.pm * 256 + ai * 128 + wr * 64 + m * 16 + fr;
                f32x4 g0 = acc[ai][0][m][0], g1 = acc[ai][0][m][1];
                const f32x4 u0 = acc[ai][1][m][0], u1 = acc[ai][1][m][1];
#pragma unroll
                for (int j = 0; j < 4; ++j) { g0[j] = fsilu(g0[j]) * u0[j]; g1[j] = fsilu(g1[j]) * u1[j]; }
                *(u32x4*)(HE + (size_t)row * 512 + u.pn * 128 + wc * 32 + 8 * fq) = pack8(g0, g1);
            }
    }
};
struct EpiDown {
    bf16_t* Y; const float* WL;
    __device__ __forceinline__ void operator()(EPI_ARGS) const {
#pragma unroll
        for (int ai = 0; ai < 2; ++ai)
#pragma unroll
            for (int m = 0; m < 4; ++m) {
                const int idx = ai * 128 + wr * 64 + m * 16 + fr;
                const int row = u.pm * 256 + idx;
                const float w = idx < u.nv ? WL[u.e * T + u.rt * 256 + idx] : 0.f;
#pragma unroll
                for (int bj = 0; bj < 2; ++bj) {
                    const int col = u.pn * 256 + bj * 128 + wc * 32 + 8 * fq;
                    *(u32x4*)(Y + (size_t)row * 1024 + col) = pack8(acc[ai][bj][m][0] * w, acc[ai][bj][m][1] * w);
                }
            }
    }
};
}

namespace att {
constexpr int NW = 8, QBLK = 32, KVBLK = 64;
constexpr float SCALE = 0.10206207261596575f;
constexpr float THR = 8.f;
constexpr int SHM_V = 8192, SHM_K = 16384;
constexpr int OFF_V = 0, OFF_K = 2 * SHM_V, OFF_WS = OFF_K + 2 * SHM_K;
#define KSWZ(row, colB) ((row) * 256 + ((colB) ^ (((row) & 7) << 4)))
#define SBAR() __builtin_amdgcn_sched_barrier(0)
__device__ __forceinline__ int crow(int r, int hi) { return (r & 3) + 8 * (r >> 2) + 4 * hi; }
__device__ __forceinline__ unsigned cvtpk(float lo, float hi) { return cvt_pk_bf16(lo, hi); }
__device__ __forceinline__ void partialSM(f32x16& p0, f32x16& p1, float& m_reg, float& mn, float& alpha) {
  constexpr float C = SCALE * 1.4426950408889634f;
  float pmax = p0[0];
#pragma unroll
  for (int r = 1; r < 16; ++r) pmax = fmaxf(pmax, p0[r]);
#pragma unroll
  for (int r = 0; r < 16; ++r) pmax = fmaxf(pmax, p1[r]);
  { auto rr = __builtin_amdgcn_permlane32_swap(__float_as_uint(pmax), __float_as_uint(pmax), false, false);
    pmax = fmaxf(__uint_as_float(rr[0]), __uint_as_float(rr[1])); }
  if (__builtin_expect(__all(pmax - m_reg <= THR / SCALE), 1)) { mn = m_reg; alpha = 1.f; }
  else { mn = fmaxf(m_reg, pmax); alpha = __builtin_amdgcn_exp2f((m_reg - mn) * C); m_reg = mn; }
  float mnC = -mn * C;
#pragma unroll
  for (int r = 0; r < 16; ++r) p0[r] = fmaf(p0[r], C, mnC);
#pragma unroll
  for (int r = 0; r < 16; ++r) p1[r] = fmaf(p1[r], C, mnC);
#pragma unroll
  for (int r = 0; r < 16; ++r) p0[r] = __builtin_amdgcn_exp2f(p0[r]);
}
__device__ __forceinline__ void finishSM(f32x16& p0, f32x16& p1, float alpha, float& l_reg, bf16x8& pa0, bf16x8& pa1, bf16x8& pa2, bf16x8& pa3) {
#pragma unroll
  for (int r = 0; r < 16; ++r) p1[r] = __builtin_amdgcn_exp2f(p1[r]);
  float ps = 0;
#pragma unroll
  for (int r = 0; r < 16; ++r) ps += p0[r];
#pragma unroll
  for (int r = 0; r < 16; ++r) ps += p1[r];
  { auto rr = __builtin_amdgcn_permlane32_swap(__float_as_uint(ps), __float_as_uint(ps), false, false);
    ps = __uint_as_float(rr[0]) + __uint_as_float(rr[1]); }
  l_reg = l_reg * alpha + ps;
#define PK4(P, BASE, OUT) do { unsigned a0 = cvtpk(P[BASE + 0], P[BASE + 1]), a1 = cvtpk(P[BASE + 2], P[BASE + 3]);   \
    unsigned b0 = cvtpk(P[BASE + 4], P[BASE + 5]), b1 = cvtpk(P[BASE + 6], P[BASE + 7]);                              \
    auto r0 = __builtin_amdgcn_permlane32_swap(a0, b0, false, false); auto r1 = __builtin_amdgcn_permlane32_swap(a1, b1, false, false); \
    u32x4 w = {r0[0], r1[0], r0[1], r1[1]}; OUT = __builtin_bit_cast(bf16x8, w); } while (0)
  PK4(p0, 0, pa0); PK4(p0, 8, pa1); PK4(p1, 0, pa2); PK4(p1, 8, pa3);
#undef PK4
}
__device__ __forceinline__ void qkt(f32x16& p0, f32x16& p1, const LAS char* Ks, const bf16x8* qr, int r32, int hi) {
  p0 = f32x16{}; p1 = f32x16{};
#pragma unroll
  for (int d0 = 0; d0 < 6; ++d0) { const int cb = (d0 * 16 + hi * 8) * 2;
    const bf16x8 b0 = *(const LAS bf16x8*)(Ks + KSWZ(r32, cb));
    const bf16x8 b1 = *(const LAS bf16x8*)(Ks + KSWZ(32 + r32, cb));
    p0 = __builtin_amdgcn_mfma_f32_32x32x16_bf16(b0, qr[d0], p0, 0, 0, 0);
    p1 = __builtin_amdgcn_mfma_f32_32x32x16_bf16(b1, qr[d0], p1, 0, 0, 0); }
}
__device__ __forceinline__ int v_st(int k, int c) { const int kk = (k & ~0xC) | ((k & 4) << 1) | ((k & 8) >> 1); return ((kk >> 3) * 2 + (c >> 5)) * 512 + ((kk & 7) * 32 + (c & 31)) * 2; }
__device__ __forceinline__ int v_rd_base(int lane) { return ((lane & 3) << 3) | (((lane >> 2) & 3) << 6) | (((lane >> 4) & 1) << 5) | (((lane >> 5) & 1) << 8); }
constexpr int v_rd_off(int d0, int ks, int half) { return d0 * 512 + ks * 2048 + half * 1024; }
template <int OFF> __device__ __forceinline__ s16x4 tr_read(int vb) {
  s16x4 r; asm volatile("ds_read_b64_tr_b16 %0, %1 offset:%2" : "=&v"(r) : "v"(vb), "i"(OFF) : "memory"); return r;
}
template <int D0> __device__ __forceinline__ void pv_one(f32x16& od, int vb, bf16x8 pa0, bf16x8 pa1, bf16x8 pa2, bf16x8 pa3) {
  const s16x4 l0 = tr_read<v_rd_off(D0, 0, 0)>(vb), h0 = tr_read<v_rd_off(D0, 0, 1)>(vb), l1 = tr_read<v_rd_off(D0, 1, 0)>(vb), h1 = tr_read<v_rd_off(D0, 1, 1)>(vb);
  const s16x4 l2 = tr_read<v_rd_off(D0, 2, 0)>(vb), h2 = tr_read<v_rd_off(D0, 2, 1)>(vb), l3 = tr_read<v_rd_off(D0, 3, 0)>(vb), h3 = tr_read<v_rd_off(D0, 3, 1)>(vb);
  asm volatile("s_waitcnt lgkmcnt(0)" ::: "memory"); SBAR();
#define PK(L, H) (bf16x8){L[0], L[1], L[2], L[3], H[0], H[1], H[2], H[3]}
  od = __builtin_amdgcn_mfma_f32_32x32x16_bf16(pa0, PK(l0, h0), od, 0, 0, 0);
  od = __builtin_amdgcn_mfma_f32_32x32x16_bf16(pa1, PK(l1, h1), od, 0, 0, 0);
  od = __builtin_amdgcn_mfma_f32_32x32x16_bf16(pa2, PK(l2, h2), od, 0, 0, 0);
  od = __builtin_amdgcn_mfma_f32_32x32x16_bf16(pa3, PK(l3, h3), od, 0, 0, 0);
#undef PK
}
__device__ __forceinline__ void pv_d0(f32x16* o, int vb, bf16x8 pa0, bf16x8 pa1, bf16x8 pa2, bf16x8 pa3) {
  pv_one<0>(o[0], vb, pa0, pa1, pa2, pa3); pv_one<1>(o[1], vb, pa0, pa1, pa2, pa3);
}
__device__ __forceinline__ void maskfill(f32x16& p0, f32x16& p1) {
#pragma unroll
  for (int r = 0; r < 16; ++r) { p0[r] = -1e30f; p1[r] = -1e30f; }
}
__device__ __forceinline__ void attn_unit(int b, int h, int qb, const bf16_t* __restrict__ Q, const bf16_t* __restrict__ KN, const bf16_t* __restrict__ KPE,
                                          const bf16_t* __restrict__ V, bf16_t* __restrict__ AO, LAS char* lds, const int tid) {
  const int wid = tid >> 6, lane = tid & 63, r32 = lane & 31, hi = lane >> 5;
  LAS char* V_lds = lds + OFF_V; LAS char* K_lds = lds + OFF_K;
  LAS float* ws = (LAS float*)(lds + OFF_WS) + wid * 64; LAS float* li_l = ws; LAS float* al_l = ws + 32;
  const long rowbase = (long)b * SEQ; const int q0 = qb * 256;
  float m_reg = -1e30f, l_reg = 0; f32x16 o[2] = {}; bf16x8 qr[6];
  const bf16_t* Qw = Q + (rowbase + q0 + wid * QBLK + r32) * 768 + h * 96 + hi * 8;
#pragma unroll
  for (int d0 = 0; d0 < 6; ++d0) qr[d0] = *(const bf16x8*)(Qw + d0 * 16);
  const int sr = tid >> 3, sc = (tid & 7) * 8, srp = (tid >> 2) & 63, scp = (tid & 3) * 8;
  const bool hasp = tid < 256;
  const int vst0 = v_st(sr, sc);
  const int vb0 = (int)(unsigned)(uintptr_t)V_lds + v_rd_base(lane);
  const bf16_t* Kg = KN + rowbase * 512 + h * 64 + (long)sr * 512 + sc;
  const bf16_t* Vg = V + rowbase * 512 + h * 64 + (long)sr * 512 + sc;
  const bf16_t* Pg = KPE + rowbase * 32 + (long)srp * 32 + scp;
  bf16x8 vs0, ks0, kp0 = {};
#define SLOAD(k0) do { vs0 = *(const bf16x8*)(Vg + (long)(k0) * 512); ks0 = *(const bf16x8*)(Kg + (long)(k0) * 512); if (hasp) kp0 = *(const bf16x8*)(Pg + (long)(k0) * 32); } while (0)
#define SWRITE(bb) do { *(LAS bf16x8*)(V_lds + (bb) * SHM_V + vst0) = vs0; *(LAS bf16x8*)(K_lds + (bb) * SHM_K + KSWZ(sr, sc * 2)) = ks0; \
    if (hasp) *(LAS bf16x8*)(K_lds + (bb) * SHM_K + KSWZ(srp, (64 + scp) * 2)) = kp0; } while (0)
#define SWAIT() asm volatile("s_waitcnt vmcnt(0)" ::: "memory")
#define RESC(a) do { if (__any((a) < 1.f)) { if (hi == 0) al_l[r32] = (a); asm volatile("s_waitcnt lgkmcnt(0)" ::: "memory"); \
    _Pragma("unroll") for (int d = 0; d < 2; ++d) _Pragma("unroll") for (int r = 0; r < 16; ++r) o[d][r] *= al_l[crow(r, hi)]; } } while (0)
  const int NT = q0 / KVBLK + 4; const int vis = q0 / KVBLK + (wid >> 1);
#define MASK(P0, P1, t) do { if ((t) > vis) maskfill(P0, P1); } while (0)
  f32x16 pA0, pA1, pB0, pB1; float mnA, mnB, alA, alB; bf16x8 pa0, pa1, pa2, pa3;
  SLOAD(0); SWAIT(); SWRITE(0); __syncthreads();
  qkt(pA0, pA1, K_lds, qr, r32, hi); partialSM(pA0, pA1, m_reg, mnA, alA);
  SLOAD(KVBLK);
  SWAIT(); SWRITE(1); __syncthreads();
  for (int j = 1; j + 1 < NT; j += 2) {
    SBAR(); qkt(pB0, pB1, K_lds + SHM_K, qr, r32, hi); MASK(pB0, pB1, j);
    finishSM(pA0, pA1, alA, l_reg, pa0, pa1, pa2, pa3); SBAR();
    SLOAD((j + 1) * KVBLK); SBAR();
    pv_d0(o, vb0, pa0, pa1, pa2, pa3); partialSM(pB0, pB1, m_reg, mnB, alB);
    __syncthreads(); SWAIT(); SWRITE(0);
    RESC(alB); __syncthreads();
    SBAR(); qkt(pA0, pA1, K_lds, qr, r32, hi); MASK(pA0, pA1, j + 1);
    finishSM(pB0, pB1, alB, l_reg, pa0, pa1, pa2, pa3); SBAR();
    SLOAD((j + 2) * KVBLK); SBAR();
    pv_d0(o, vb0 + SHM_V, pa0, pa1, pa2, pa3); partialSM(pA0, pA1, m_reg, mnA, alA);
    __syncthreads(); SWAIT(); SWRITE(1);
    RESC(alA); __syncthreads();
  }
  SBAR(); qkt(pB0, pB1, K_lds + SHM_K, qr, r32, hi); MASK(pB0, pB1, NT - 1);
  finishSM(pA0, pA1, alA, l_reg, pa0, pa1, pa2, pa3); SBAR();
  pv_d0(o, vb0, pa0, pa1, pa2, pa3); partialSM(pB0, pB1, m_reg, mnB, alB);
  __syncthreads(); RESC(alB);
  finishSM(pB0, pB1, alB, l_reg, pa0, pa1, pa2, pa3); SBAR();
  pv_d0(o, vb0 + SHM_V, pa0, pa1, pa2, pa3);
  if (hi == 0) li_l[r32] = l_reg; asm volatile("s_waitcnt lgkmcnt(0)" ::: "memory");
  float rli[16];
#pragma unroll
  for (int r = 0; r < 16; ++r) rli[r] = __builtin_amdgcn_rcpf(li_l[crow(r, hi)]);
  bf16_t* Ow = AO + (rowbase + q0 + wid * QBLK) * 512 + h * 64;
#pragma unroll
  for (int r = 0; r < 16; ++r) { const int orow = crow(r, hi);
#pragma unroll
    for (int d0 = 0; d0 < 2; ++d0) Ow[(long)orow * 512 + d0 * 32 + r32] = (bf16_t)(cvtpk(o[d0][r] * rli[r], 0.f) & 0xffffu); }
  __syncthreads();
#undef SLOAD
#undef SWRITE
#undef SWAIT
#undef RESC
#undef MASK
}
#undef SBAR
}

struct Args {
    const float* x; const float* c; const int* pos; const float* ada_w; const float* ada_b; const float* norm1_g; const float* w_in; const float* lb_logits;
    const float* hg_norm_g; const float* q_norm_g; const float* w_q_up; const float* kv_norm_g; const float* w_kv_up; const float* w_br_a; const float* w_br_b;
    const float* w_out; const float* norm2_g; const float* w_router; const float* router_bias; const float* w_gate; const float* w_up; const float* w_down; const float* final_g;
    float* out; unsigned char* ws; int ph_lo, ph_hi;
};

__device__ __forceinline__ void tr_item(const float* src, int srcN, int sn0, bf16_t* dst, int dK, int dr0, int k0, const float* rs, bool il, bool zero, LAS float* scr, int lane) {
    if (!zero) {
        f32x4 v[8];
#pragma unroll
        for (int r = 0; r < 8; ++r) { const int kk = (lane >> 3) + 8 * r; v[r] = *(const f32x4*)(src + (size_t)(k0 + kk) * srcN + sn0 + (lane & 7) * 4); }
#pragma unroll
        for (int r = 0; r < 8; ++r) { const int kk = (lane >> 3) + 8 * r; f32x4 x = v[r]; if (rs) x = x * rs[k0 + kk];
            LAS float* d = scr + kk * 33 + (lane & 7) * 4; d[0] = x.x; d[1] = x.y; d[2] = x.z; d[3] = x.w; }
    }
    LDS_WAIT(); asm volatile("" ::: "memory");
    const int c = lane & 7;
#pragma unroll
    for (int j = 0; j < 4; ++j) {
        const int n = (lane >> 3) + 8 * j; const int sn = il ? ((n & 1) ? 16 + (n >> 1) : (n >> 1)) : n;
        const LAS float* s = scr + (8 * c) * 33 + sn;
        u32x4 o;
        if (zero) { unsigned z = 0u; asm volatile("" : "+v"(z)); o = (u32x4){z, z, z, z}; }
        else { o.x = cvt_pk_bf16(s[0 * 33], s[1 * 33]); o.y = cvt_pk_bf16(s[2 * 33], s[3 * 33]); o.z = cvt_pk_bf16(s[4 * 33], s[5 * 33]); o.w = cvt_pk_bf16(s[6 * 33], s[7 * 33]); }
        *(u32x4*)(dst + (size_t)(dr0 + n) * dK + k0 + 8 * c) = o;
    }
    LDS_WAIT(); asm volatile("" ::: "memory");
}
__device__ __forceinline__ void conv_weights(const Args& a, int l, LAS unsigned char* lds, int gw, int NGW, int wave, int lane) {
    LAS float* scr = (LAS float*)(lds + wave * 16384);
    bf16_t* WT = (bf16_t*)(a.ws + WS_WT);
    constexpr int I_IN = 16 * 152, I_QU = 6 * 24, I_KV = 4 * 32, I_BR = 8 * 32, I_OUT = 16 * 32, I_GU = NE * 16 * 32, I_DN = NE * 8 * 32;
    constexpr int NIT = I_IN + I_QU + I_KV + 2 * I_BR + I_OUT + I_GU + I_DN;
    for (int it = gw; it < NIT; it += NGW) {
        int r = it;
        if (r < I_IN) { const int kb = r / 152, db = r % 152; int sn0; bool il = false, zero = false;
            if (db < 64) sn0 = 32 * db; else if (db < 128) sn0 = 2720 + 32 * (db - 64); else if (db < 136) sn0 = 2432 + 32 * (db - 128); else if (db < 148) sn0 = 2048 + 32 * (db - 136);
            else if (db == 148) { sn0 = 2688; il = true; } else { sn0 = 0; zero = true; }
            tr_item(a.w_in + (size_t)l * 1024 * INCOLS, INCOLS, sn0, WT + WT_IN / 2, 1024, 32 * db, 64 * kb, nullptr, il, zero, scr, lane); continue; }
        r -= I_IN;
        if (r < I_QU) { const int kb = r / 24, db = r % 24;
            tr_item(a.w_q_up + (size_t)l * 384 * 768, 768, 32 * db, WT + WT_QU / 2, 384, 32 * db, 64 * kb, a.q_norm_g + l * 384, (db % 3) == 2, false, scr, lane); continue; }
        r -= I_QU;
        if (r < I_KV) { const int kb = r / 32, db = r % 32; const int hh = (db & 15) >> 1, half = db & 1; const int sn0 = hh * 128 + (db >= 16 ? 64 : 0) + 32 * half;
            tr_item(a.w_kv_up + (size_t)l * 256 * 1024, 1024, sn0, WT + WT_KV / 2, 256, 32 * db, 64 * kb, a.kv_norm_g + l * 256, false, false, scr, lane); continue; }
        r -= I_KV;
        if (r < I_BR) { const int kb = r / 32, db = r % 32; tr_item(a.w_br_a + (size_t)l * 512 * 1024, 1024, 32 * db, WT + WT_BA / 2, 512, 32 * db, 64 * kb, nullptr, false, false, scr, lane); continue; }
        r -= I_BR;
        if (r < I_BR) { const int kb = r / 32, db = r % 32; tr_item(a.w_br_b + (size_t)l * 512 * 1024, 1024, 32 * db, WT + WT_BB / 2, 512, 32 * db, 64 * kb, nullptr, false, false, scr, lane); continue; }
        r -= I_BR;
        if (r < I_OUT) { const int kb = r / 32, db = r % 32; tr_item(a.w_out + (size_t)l * 1024 * 1024, 1024, 32 * db, WT + WT_OUT / 2, 1024, 32 * db, 64 * kb, nullptr, false, false, scr, lane); continue; }
        r -= I_OUT;
        if (r < I_GU) { const int e = r / 512, q = r % 512, kb = q / 32, db = q % 32; const int pn = db >> 3, rr = db & 7;
            const float* src = (rr < 4 ? a.w_gate : a.w_up) + ((size_t)l * NE + e) * 1024 * 512;
            tr_item(src, 512, 128 * pn + 32 * (rr & 3), WT + WT_GU / 2 + (size_t)e * 1024 * 1024, 1024, 32 * db, 64 * kb, nullptr, false, false, scr, lane); continue; }
        r -= I_GU;
        { const int e = r / 256, q = r % 256, kb = q / 32, db = q % 32;
            tr_item(a.w_down + ((size_t)l * NE + e) * 512 * 1024, 1024, 32 * db, WT + WT_DN / 2 + (size_t)e * 1024 * 512, 512, 32 * db, 64 * kb, nullptr, false, false, scr, lane); }
    }
}
__device__ __forceinline__ void mod_phase(const Args& a, LAS unsigned char* lds, int tid, int wave, int lane) {
    LAS float* ca = (LAS float*)lds;
    LAS float* red = (LAS float*)(lds + 16384);
    float* mod = (float*)(a.ws + WS_MOD);
    for (int i = tid; i < 4096; i += NTHR) ca[i] = fsilu(a.c[i]);
    __syncthreads();
    for (int u = blockIdx.x; u < 192; u += gridDim.x) {
        const int l = u / 96, n0 = (u % 96) * 64;
        const float* W = a.ada_w + (size_t)l * 1024 * 6144 + n0 + lane;
        float s0 = 0.f, s1 = 0.f, s2 = 0.f, s3 = 0.f;
        const int kb = wave * 128;
#pragma unroll 8
        for (int k = 0; k < 128; ++k) { const float w = W[(size_t)(kb + k) * 6144]; s0 += ca[kb + k] * w; s1 += ca[1024 + kb + k] * w; s2 += ca[2048 + kb + k] * w; s3 += ca[3072 + kb + k] * w; }
        red[(wave * 4 + 0) * 64 + lane] = s0; red[(wave * 4 + 1) * 64 + lane] = s1; red[(wave * 4 + 2) * 64 + lane] = s2; red[(wave * 4 + 3) * 64 + lane] = s3;
        __syncthreads();
        if (tid < 256) { const int b = tid >> 6, col = tid & 63; float s = a.ada_b[l * 6144 + n0 + col];
#pragma unroll
            for (int w = 0; w < 8; ++w) s += red[(w * 4 + b) * 64 + col];
            mod[((size_t)l * 4 + b) * 6144 + n0 + col] = s; }
        __syncthreads();
    }
}
__device__ __forceinline__ void rope_phase(const Args& a, int gtid, int ngt) {
    f32x2* rope = (f32x2*)(a.ws + WS_ROPE);
    for (int i = gtid; i < T * 16; i += ngt) {
        const int t = i >> 4, k = i & 15;
        const double inv = exp(-(double)k * (9.210340371976184 / 16.0));
        const double ang = (double)a.pos[t] * inv;
        const double n = rint(ang * 0.15915494309189535);
        double r = fma(-n, 6.283185307179586, ang); r = fma(-n, 2.4492935982947064e-16, r);
        rope[i] = (f32x2){(float)cos(r), (float)sin(r)};
    }
}
__device__ __forceinline__ void norm_row(const float* xrow, bf16_t* orow, const float* g, const float* sc, const float* sh, int lane, f32x4 (&hv)[4]) {
    const f32x4* xr = (const f32x4*)xrow + lane;
    f32x4 v[4]; float s = 0.f;
#pragma unroll
    for (int j = 0; j < 4; ++j) { v[j] = xr[64 * j]; s += (v[j].x * v[j].x + v[j].y * v[j].y) + (v[j].z * v[j].z + v[j].w * v[j].w); }
    const float rstd = __builtin_amdgcn_rsqf(wave_sum(s) * (1.f / 1024.f) + EPS);
    u32x2* o8 = (u32x2*)orow + lane;
#pragma unroll
    for (int j = 0; j < 4; ++j) {
        const f32x4 gg = ((const f32x4*)g)[lane + 64 * j], cc = ((const f32x4*)sc)[lane + 64 * j], hh = ((const f32x4*)sh)[lane + 64 * j];
        f32x4 h = v[j] * rstd * gg * (cc + 1.f) + hh; hv[j] = h;
        u32x2 w; w.x = cvt_pk_bf16(h.x, h.y); w.y = cvt_pk_bf16(h.z, h.w); o8[64 * j] = w;
    }
}

__device__ __forceinline__ float tr_reduce16(const float (&a)[16], int lane) {
    float v[8];
    const bool b5 = (lane & 32) != 0;
#pragma unroll
    for (int i = 0; i < 8; ++i) { const float own = b5 ? a[i + 8] : a[i], snd = b5 ? a[i] : a[i + 8]; v[i] = own + __shfl_xor(snd, 32); }
    const bool b4 = (lane & 16) != 0;
#pragma unroll
    for (int i = 0; i < 4; ++i) { const float own = b4 ? v[i + 4] : v[i], snd = b4 ? v[i] : v[i + 4]; v[i] = own + __shfl_xor(snd, 16); }
    const bool b3 = (lane & 8) != 0;
#pragma unroll
    for (int i = 0; i < 2; ++i) { const float own = b3 ? v[i + 2] : v[i], snd = b3 ? v[i] : v[i + 2]; v[i] = own + __shfl_xor(snd, 8); }
    const bool b2 = (lane & 4) != 0;
    float r; { const float own = b2 ? v[1] : v[0], snd = b2 ? v[0] : v[1]; r = own + __shfl_xor(snd, 4); }
    r += __shfl_xor(r, 2); r += __shfl_xor(r, 1);
    return r;
}
constexpr int H1_BF = 0, H1_QT = 33792, H1_KT = H1_QT + 17408, H1_VT = H1_KT + 17408, H1_KD = H1_VT + 18432, H1_AT = H1_KD + 18432, H1_SEG = H1_AT + 9216, H1_END = H1_SEG + 2048;
static_assert(H1_END <= LDS_SCR_BYTES, "H1 LDS");
__device__ __forceinline__ void h1_unit(int u, bf16_t* QH, const bf16_t* LF, bf16_t* VH, bf16_t* UT, float* AC, LAS unsigned char* lds, int tid, int wave, int lane, bool dry = false) {
    LAS float* Bf = (LAS float*)(lds + H1_BF);
    LAS bf16_t* Qt = (LAS bf16_t*)(lds + H1_QT);
    LAS bf16_t* Kt = (LAS bf16_t*)(lds + H1_KT);
    LAS bf16_t* VT = (LAS bf16_t*)(lds + H1_VT);
    LAS bf16_t* KdT = (LAS bf16_t*)(lds + H1_KD);
    LAS bf16_t* At = (LAS bf16_t*)(lds + H1_AT);
    LAS float* seg = (LAS float*)(lds + H1_SEG);
    const int bh = u >> 6, c = u & 63, b = bh >> 2, h = bh & 3;
    const size_t rowbase = (size_t)b * SEQ + (size_t)c * 64; const int col0 = h * 128;
    u32x4 qv[2], lv[2], vv[2];
#pragma unroll
    for (int i = 0; i < 2; ++i) { const int ch = wave + 8 * i; const size_t o = (rowbase + lane) * 512 + col0 + ch * 8;
        qv[i] = *(const u32x4*)(QH + o); lv[i] = *(const u32x4*)(LF + o); vv[i] = *(const u32x4*)(VH + o); }
#pragma unroll
    for (int i = 0; i < 2; ++i) { const int ch = wave + 8 * i; f32x4 a0, a1; unpack8(lv[i], a0, a1);
        *(LAS f32x4*)(Bf + lane * 132 + ch * 8) = a0; *(LAS f32x4*)(Bf + lane * 132 + ch * 8 + 4) = a1; }
    __syncthreads();
    { const int d = tid & 127, sg = tid >> 7; float run = 0.f;
#pragma unroll
        for (int r = 0; r < 16; ++r) { run += Bf[(sg * 16 + r) * 132 + d]; Bf[(sg * 16 + r) * 132 + d] = run; }
        seg[sg * 128 + d] = run;
        __syncthreads();
        float off = 0.f;
#pragma unroll
        for (int s = 0; s < 3; ++s) off += (s < sg) ? seg[s * 128 + d] : 0.f;
        if (sg > 0) {
#pragma unroll
            for (int r = 0; r < 16; ++r) Bf[(sg * 16 + r) * 132 + d] += off;
        }
    }
    __syncthreads();
#pragma unroll
    for (int i = 0; i < 2; ++i) {
        const int ch = wave + 8 * i, s = lane;
        f32x4 q0, q1, l0, l1, bb0, bb1, bl0, bl1, bm0, bm1;
        unpack8(qv[i], q0, q1); unpack8(lv[i], l0, l1);
        bb0 = *(const LAS f32x4*)(Bf + s * 132 + ch * 8); bb1 = *(const LAS f32x4*)(Bf + s * 132 + ch * 8 + 4);
        bl0 = *(const LAS f32x4*)(Bf + 63 * 132 + ch * 8); bl1 = *(const LAS f32x4*)(Bf + 63 * 132 + ch * 8 + 4);
        bm0 = *(const LAS f32x4*)(Bf + 31 * 132 + ch * 8); bm1 = *(const LAS f32x4*)(Bf + 31 * 132 + ch * 8 + 4);
        f32x4 qt0, qt1, kt0, kt1, kd0, kd1, qh0, qh1;
#pragma unroll
        for (int j = 0; j < 4; ++j) {
            const float k0 = 1.f - fexp(l0[j]), k1 = 1.f - fexp(l1[j]);
            qt0[j] = q0[j] * fexp(bb0[j] - bm0[j]); qt1[j] = q1[j] * fexp(bb1[j] - bm1[j]);
            kt0[j] = k0 * fexp(bm0[j] - bb0[j]); kt1[j] = k1 * fexp(bm1[j] - bb1[j]);
            kd0[j] = k0 * fexp(bl0[j] - bb0[j]); kd1[j] = k1 * fexp(bl1[j] - bb1[j]);
            qh0[j] = q0[j] * fexp(bb0[j]); qh1[j] = q1[j] * fexp(bb1[j]);
        }
        *(LAS u32x4*)(Qt + s * 136 + ch * 8) = pack8(qt0, qt1);
        *(LAS u32x4*)(Kt + s * 136 + ch * 8) = pack8(kt0, kt1);
        const u32x4 kdp = pack8(kd0, kd1);
#pragma unroll
        for (int j = 0; j < 4; ++j) {
            const unsigned kx = (unsigned)__shfl_xor((int)kdp[j], 1), vx = (unsigned)__shfl_xor((int)vv[i][j], 1);
            const bool odd = (s & 1) != 0; const int se = s & ~1;
            const unsigned kw = odd ? ((kx >> 16) | (kdp[j] & 0xffff0000u)) : ((kdp[j] & 0xffffu) | (kx << 16));
            const unsigned vw = odd ? ((vx >> 16) | (vv[i][j] & 0xffff0000u)) : ((vv[i][j] & 0xffffu) | (vx << 16));
            *(LAS unsigned*)(KdT + (ch * 8 + 2 * j + (odd ? 1 : 0)) * 72 + se) = kw;
            *(LAS unsigned*)(VT + (ch * 8 + 2 * j + (odd ? 1 : 0)) * 72 + se) = vw;
        }
        if (!dry) *(u32x4*)(QH + (rowbase + s) * 512 + col0 + ch * 8) = pack8(qh0, qh1);
        if (s == 63 && !dry) { float* ac = AC + (size_t)u * 128 + ch * 8;
#pragma unroll
            for (int j = 0; j < 4; ++j) { ac[j] = fexp(bl0[j]); ac[4 + j] = fexp(bl1[j]); } }
    }
    __syncthreads();
    const int l15 = lane & 15, lq = lane >> 4;
    { const int tr = wave >> 1;
#pragma unroll
        for (int tci = 0; tci < 2; ++tci) { const int tc = (wave & 1) * 2 + tci; f32x4 acc = {0.f, 0.f, 0.f, 0.f};
            if (tc <= tr) {
#pragma unroll
                for (int ks = 0; ks < 4; ++ks) { const bf16x8 af = *(const LAS bf16x8*)(Qt + (16 * tr + l15) * 136 + 32 * ks + 8 * lq), bf = *(const LAS bf16x8*)(Kt + (16 * tc + l15) * 136 + 32 * ks + 8 * lq);
                    acc = __builtin_amdgcn_mfma_f32_16x16x32_bf16(af, bf, acc, 0, 0, 0); }
            }
#pragma unroll
            for (int r = 0; r < 4; ++r) { const int t = 16 * tr + 4 * lq + r, s = 16 * tc + l15; const float v = (s <= t) ? acc[r] : 0.f; const float vn = __shfl_xor(v, 1);
                if ((l15 & 1) == 0) *(LAS unsigned*)(At + t * 72 + s) = cvt_pk_bf16(v, vn); } }
    }
    __syncthreads();
    { const int vt = wave;
        bf16x8 af[2];
#pragma unroll
        for (int ks = 0; ks < 2; ++ks) af[ks] = *(const LAS bf16x8*)(VT + (16 * vt + l15) * 72 + 32 * ks + 8 * lq);
#pragma unroll
        for (int tt = 0; tt < 4; ++tt) { f32x4 acc = {0.f, 0.f, 0.f, 0.f};
#pragma unroll
            for (int ks = 0; ks < 2; ++ks) { const bf16x8 bf = *(const LAS bf16x8*)(At + (16 * tt + l15) * 72 + 32 * ks + 8 * lq); acc = __builtin_amdgcn_mfma_f32_16x16x32_bf16(af[ks], bf, acc, 0, 0, 0); }
            u32x2 w; w.x = cvt_pk_bf16(acc[0], acc[1]); w.y = cvt_pk_bf16(acc[2], acc[3]);
            if (!dry) *(u32x2*)(VH + (rowbase + 16 * tt + l15) * 512 + col0 + 16 * vt + 4 * lq) = w; }
    }
    { const int dt = wave;
        bf16x8 af[2];
#pragma unroll
        for (int ks = 0; ks < 2; ++ks) af[ks] = *(const LAS bf16x8*)(KdT + (16 * dt + l15) * 72 + 32 * ks + 8 * lq);
#pragma unroll
        for (int vt = 0; vt < 8; ++vt) { f32x4 acc = {0.f, 0.f, 0.f, 0.f};
#pragma unroll
            for (int ks = 0; ks < 2; ++ks) { const bf16x8 bf = *(const LAS bf16x8*)(VT + (16 * vt + l15) * 72 + 32 * ks + 8 * lq); acc = __builtin_amdgcn_mfma_f32_16x16x32_bf16(af[ks], bf, acc, 0, 0, 0); }
            u32x2 w; w.x = cvt_pk_bf16(acc[0], acc[1]); w.y = cvt_pk_bf16(acc[2], acc[3]);
            if (!dry) *(u32x2*)(UT + ((size_t)u * 128 + 16 * vt + l15) * 128 + 16 * dt + 4 * lq) = w; }
    }
    __syncthreads();
}
__device__ __forceinline__ void h2_scan(bf16_t* UT, const float* AC, int tid, bool dry = false) {
    if (tid >= 256) return;
    for (int w = blockIdx.x * 256 + tid; w < 16 * 128 * 32; w += gridDim.x * 256) {
        const int bh = w >> 12, rem = w & 4095, v = rem >> 5, dq = rem & 31;
        bf16_t* p = UT + ((size_t)bh * 64 * 128 + v) * 128 + 4 * dq;
        const float* ap = AC + (size_t)bh * 64 * 128 + 4 * dq;
        f32x4 S = {0.f, 0.f, 0.f, 0.f};
        for (int c0 = 0; c0 < 64; c0 += 8) {
            u32x2 uu[8]; f32x4 aa[8];
#pragma unroll
            for (int k = 0; k < 8; ++k) { uu[k] = *(const u32x2*)(p + (size_t)(c0 + k) * 16384); aa[k] = *(const f32x4*)(ap + (size_t)(c0 + k) * 128); }
#pragma unroll
            for (int k = 0; k < 8; ++k) {
                u32x2 w2; w2.x = cvt_pk_bf16(S.x, S.y); w2.y = cvt_pk_bf16(S.z, S.w);
                if (!dry) *(u32x2*)(p + (size_t)(c0 + k) * 16384) = w2;
                const f32x4 uf = {bflo(uu[k].x), bfhi(uu[k].x), bflo(uu[k].y), bfhi(uu[k].y)};
                S = aa[k] * S + uf;
            }
        }
    }
}
__device__ __forceinline__ void h3_tile(int u, int tt, const bf16_t* QH, const bf16_t* VH, const bf16_t* HG, const bf16_t* UT, const float* gn, bf16_t* OA, int lane) {
    const int bh = u >> 6, c = u & 63, b = bh >> 2, h = bh & 3;
    const size_t row = (size_t)b * SEQ + (size_t)c * 64 + 16 * tt + (lane & 15); const int col0 = h * 128;
    const int l15 = lane & 15, lq = lane >> 4;
    bf16x8 bq[4];
#pragma unroll
    for (int ks = 0; ks < 4; ++ks) bq[ks] = *(const bf16x8*)(QH + row * 512 + col0 + 32 * ks + 8 * lq);
    f32x4 acc[8];
#pragma unroll
    for (int vt = 0; vt < 8; ++vt) { acc[vt] = (f32x4){0.f, 0.f, 0.f, 0.f};
#pragma unroll
        for (int ks = 0; ks < 4; ++ks) { const bf16x8 af = *(const bf16x8*)(UT + ((size_t)u * 128 + 16 * vt + l15) * 128 + 32 * ks + 8 * lq);
            acc[vt] = __builtin_amdgcn_mfma_f32_16x16x32_bf16(af, bq[ks], acc[vt], 0, 0, 0); } }
    float ss = 0.f;
#pragma unroll
    for (int vt = 0; vt < 8; ++vt) { const u32x2 iw = *(const u32x2*)(VH + row * 512 + col0 + 16 * vt + 4 * lq);
        acc[vt].x += bflo(iw.x); acc[vt].y += bfhi(iw.x); acc[vt].z += bflo(iw.y); acc[vt].w += bfhi(iw.y);
        ss += (acc[vt].x * acc[vt].x + acc[vt].y * acc[vt].y) + (acc[vt].z * acc[vt].z + acc[vt].w * acc[vt].w); }
    ss += __shfl_xor(ss, 16); ss += __shfl_xor(ss, 32);
    const float rstd = __builtin_amdgcn_rsqf(ss * (1.f / 128.f) + EPS);
#pragma unroll
    for (int vt = 0; vt < 8; ++vt) { const int cc = col0 + 16 * vt + 4 * lq;
        const f32x4 g = *(const f32x4*)(gn + cc); const u32x2 gw = *(const u32x2*)(HG + row * 512 + cc);
        const f32x4 o = acc[vt] * rstd * g * (f32x4){bflo(gw.x), bfhi(gw.x), bflo(gw.y), bfhi(gw.y)};
        u32x2 w; w.x = cvt_pk_bf16(o.x, o.y); w.y = cvt_pk_bf16(o.z, o.w);
        *(u32x2*)(OA + row * 512 + cc) = w; }
}

__device__ __forceinline__ Args load_args() {
#if defined(__HIP_DEVICE_COMPILE__)
    const __attribute__((address_space(4))) Args* ap = (const __attribute__((address_space(4))) Args*)__builtin_amdgcn_kernarg_segment_ptr();
    asm volatile("" : "+s"(ap));
    return *ap;
#else
    return Args{};
#endif
}
#define FRESH() int tid = tid0; asm volatile("" : "+v"(tid)); \
    const Args a = load_args(); \
    unsigned char* ws = a.ws; float* xo = a.out; \
    const int lane = tid & 63; const int wave = __builtin_amdgcn_readfirstlane(tid >> 6); const int gw = bx * NWAVES + wave; (void)lane; (void)wave; (void)gw; (void)xo
#define WSP(Tp, off) ((Tp*)(ws + (off)))
__global__ void __launch_bounds__(NTHR, 2) fwd(Args kargs) {
    extern __shared__ __attribute__((aligned(16))) unsigned char lds_raw[];
    LAS unsigned char* lds = (LAS unsigned char*)lds_raw;
    const int tid0 = threadIdx.x;
    const int G = gridDim.x, bx = blockIdx.x;
    const int NGW = G * NWAVES;
    unsigned* ctl = (unsigned*)(kargs.ws + WS_CTL);
    volatile LAS unsigned* MISC = (volatile LAS unsigned*)(lds + LDS_MISC);
    LAS int* UL = (LAS int*)(lds + LDS_MISC + 64);
    LAS int* NUN = (LAS int*)(lds + LDS_MISC + 512);
    LAS int* TCUM = (LAS int*)(lds + LDS_MISC + 576);
    for (int i = tid0; i < 1024; i += NTHR) ((LAS unsigned*)(lds + LDS_MISC))[i] = 0u;
    __syncthreads();
    XcdBarrier bar; bar.bar = ctl + CW_BAR; bar.x = 0; bar.st = nullptr;
    if (!MK_PER_PHASE) bar = xcd_barrier_post(ctl + CW_BAR, MISC);
    const int lo = kargs.ph_lo, hi = kargs.ph_hi;
#define IN(k) (lo <= (k) && (k) < hi)
#define SEAM(k) do { if (IN(k) && IN((k) + 1)) { if (MK_PER_PHASE) { if (tid0 == 0) __hip_atomic_store(ctl + CW_BAR + XB_TMO, 0xBADu, __ATOMIC_RELAXED, __HIP_MEMORY_SCOPE_AGENT); } else xcd_barrier(bar); } } while (0)

    if (PHEN(0) && IN(0)) {
        FRESH();
        for (int rep = 0; rep < REPS(14); ++rep) { mod_phase(a, lds, tid, wave, lane);
        rope_phase(a, bx * NTHR + tid, G * NTHR); }
        if (bx == G - 1) { float* lbv = WSP(float, WS_LB); for (int j = tid; j < 512; j += NTHR) { lbv[j] = 0.f; lbv[512 + j] = fsigmoid(a.lb_logits[512 + j] - a.lb_logits[j]); } }
        for (int rep = 0; rep < REPS(0); ++rep) conv_weights(a, 0, lds, gw, NGW, wave, lane);
    }
    SEAM(0);
    if (PHEN(1) && IN(1)) for (int rep = 0; rep < REPS(1); ++rep) {
        FRESH();
        const float* mod = WSP(float, WS_MOD); bf16_t* HN = WSP(bf16_t, WS_HN);
        for (int m = gw; m < T; m += NGW) { const float* mb = mod + (size_t)(m >> 12) * 6144; f32x4 hv[4];
            norm_row(a.x + (size_t)m * 1024, HN + (size_t)m * 1024, a.norm1_g, mb + 1024, mb, lane, hv); }
    }
    SEAM(1);
    int ph = 2;
    for (int l = 0; l < DEPTH; ++l) {
        if (PHEN(2) && IN(ph)) for (int rep = 0; rep < REPS(2); ++rep) {
            FRESH();
            pg8::ProbDense P; P.A = (const char*)WSP(bf16_t, WS_HN); P.Bt = (const char*)WSP(bf16_t, WS_WT + WT_IN); P.lda = 1024; P.ldb = 1024; P.K = 1024; P.S.init(T, NPROJ, G, bx);
            pg8::EpiProj E{WSP(bf16_t, WS_P + P_QH), WSP(bf16_t, WS_P + P_LF), WSP(bf16_t, WS_P + P_VH), WSP(bf16_t, WS_P + P_HG), WSP(bf16_t, WS_P + P_GT), WSP(bf16_t, WS_P + P_CKV),
                           WSP(bf16_t, WS_P + P_CQ), WSP(bf16_t, WS_P + P_KPE), WSP(float, WS_SSQKV), WSP(float, WS_SSQQ), WSP(float, WS_LB) + l * 512, WSP(const f32x2, WS_ROPE)};
            pg8::gemm_phase(lds, P, E, tid);
        }
        SEAM(ph); ++ph;
        if (PHEN(3) && IN(ph)) {
            for (int rep = 0; rep < REPS(3); ++rep) {
            if (!DBG_NOUP) { FRESH(); pg8::ProbDense P; P.A = (const char*)WSP(bf16_t, WS_P + P_CQ); P.Bt = (const char*)WSP(bf16_t, WS_WT + WT_QU); P.lda = 512; P.ldb = 384; P.K = 384; P.S.init(T, 768, G, bx);
              pg8::EpiQup E{WSP(bf16_t, WS_Q), WSP(float, WS_SSQQ), WSP(const f32x2, WS_ROPE)}; pg8::gemm_phase(lds, P, E, tid); }
            if (!DBG_NOUP) { FRESH(); pg8::ProbDense P; P.A = (const char*)WSP(bf16_t, WS_P + P_CKV); P.Bt = (const char*)WSP(bf16_t, WS_WT + WT_KV); P.lda = 256; P.ldb = 256; P.K = 256; P.S.init(T, 1024, G, (bx + 192) % G);
              pg8::EpiKVup E{WSP(bf16_t, WS_KN), WSP(bf16_t, WS_V), WSP(float, WS_SSQKV)}; pg8::gemm_phase(lds, P, E, tid); }
            }
            __syncthreads();
            { FRESH();
              for (int rep = 0; rep < REPS(12); ++rep) for (int u = bx; u < 1024; u += G) h1_unit(u, WSP(bf16_t, WS_P + P_QH), WSP(bf16_t, WS_P + P_LF), WSP(bf16_t, WS_P + P_VH), WSP(bf16_t, WS_UT), WSP(float, WS_AC), lds, tid, wave, lane, rep > 0 && hi < 100000); }
        }
        SEAM(ph); ++ph;
        if (PHEN(4) && IN(ph)) for (int rep = 0; rep < REPS(4); ++rep) { FRESH(); h2_scan(WSP(bf16_t, WS_UT), WSP(float, WS_AC), tid, rep > 0 && hi < 100000); }
        SEAM(ph); ++ph;
        if (PHEN(5) && IN(ph)) {
            for (int rep = 0; rep < REPS(5); ++rep) { FRESH();
              for (int p = bx; p < 256; p += G) { const int bh = p >> 3, s = p & 7;
                att::attn_unit(bh >> 3, bh & 7, 15 - s, WSP(bf16_t, WS_Q), WSP(bf16_t, WS_KN), WSP(bf16_t, WS_P + P_KPE), WSP(bf16_t, WS_V), WSP(bf16_t, WS_AO), (LAS char*)lds, tid);
                att::attn_unit(bh >> 3, bh & 7, s, WSP(bf16_t, WS_Q), WSP(bf16_t, WS_KN), WSP(bf16_t, WS_P + P_KPE), WSP(bf16_t, WS_V), WSP(bf16_t, WS_AO), (LAS char*)lds, tid); } }
            for (int rep = 0; rep < REPS(13); ++rep) { FRESH();
              for (int w = gw; w < 4096; w += NGW) h3_tile(w >> 2, w & 3, WSP(bf16_t, WS_P + P_QH), WSP(bf16_t, WS_P + P_VH), WSP(bf16_t, WS_P + P_HG), WSP(bf16_t, WS_UT), a.hg_norm_g + l * 512, WSP(bf16_t, WS_OA), lane); }
        }
        SEAM(ph); ++ph;
        if (PHEN(6) && IN(ph)) for (int rep = 0; rep < REPS(6); ++rep) {
            { FRESH(); pg8::ProbDense P; P.A = (const char*)WSP(bf16_t, WS_OA); P.Bt = (const char*)WSP(bf16_t, WS_WT + WT_BA); P.lda = 512; P.ldb = 512; P.K = 512; P.S.init(T, 1024, G, bx);
              pg8::EpiBr1 E{WSP(bf16_t, WS_TMP), WSP(bf16_t, WS_P + P_GT)}; pg8::gemm_phase(lds, P, E, tid); }
            VM_WAIT(); __syncthreads();
            { FRESH(); pg8::ProbDense P; P.A = (const char*)WSP(bf16_t, WS_AO); P.Bt = (const char*)WSP(bf16_t, WS_WT + WT_BB); P.lda = 512; P.ldb = 512; P.K = 512; P.S.init(T, 1024, G, bx);
              pg8::EpiBr2 E{WSP(bf16_t, WS_MG), WSP(bf16_t, WS_TMP), WSP(bf16_t, WS_P + P_GT)}; pg8::gemm_phase(lds, P, E, tid); }
        }
        SEAM(ph); ++ph;
        if (PHEN(7) && IN(ph)) for (int rep = 0; rep < REPS(7); ++rep) {
            FRESH();
            pg8::ProbDense P; P.A = (const char*)WSP(bf16_t, WS_MG); P.Bt = (const char*)WSP(bf16_t, WS_WT + WT_OUT); P.lda = 1024; P.ldb = 1024; P.K = 1024; P.S.init(T, 1024, G, bx);
            pg8::EpiOut E{(l == 0) ? a.x : (const float*)xo, xo, WSP(float, WS_MOD) + (size_t)l * 4 * 6144 + 2048, (rep > 0 && hi < 100000) ? 1 : 0}; pg8::gemm_phase(lds, P, E, tid);
        }
        SEAM(ph); ++ph;
        if (PHEN(8) && IN(ph)) for (int rep = 0; rep < REPS(8); ++rep) {
            FRESH(); const bool dry = rep > 0 && hi < 100000;
            const float* modl = WSP(float, WS_MOD) + (size_t)l * 4 * 6144; bf16_t* HN = WSP(bf16_t, WS_HN);
            int* TL = WSP(int, WS_TL); float* WL = WSP(float, WS_WL); int* TS = WSP(int, WS_TS);
            LAS float* wrT = (LAS float*)lds;
            LAS int* lcnt = (LAS int*)(lds + 16 * 1028 * 4);
            LAS int* rec = lcnt + 64;
            LAS float* LG = (LAS float*)(rec + 64 * 8);
            for (int i = tid; i < 16384; i += NTHR) wrT[(i & 15) * 1028 + (i >> 4)] = a.w_router[i];
            if (tid < 32) lcnt[tid] = 0;
            __syncthreads();
            constexpr int RPW = 64, RQ = 4;
            const float* g2n = a.norm2_g + l * 1024;
#pragma unroll 1
            for (int grp = 0; grp < 8 / RQ; ++grp) {
                const int rl0 = wave * 8 + grp * RQ; const int m0 = bx * RPW + rl0;
                unsigned wro = (unsigned)(4 * lane) * 4u; asm volatile("" : "+v"(wro));
                const float* mb = modl + (size_t)(m0 >> 12) * 6144;
                f32x4 hv[RQ][4]; float ssq[RQ];
#pragma unroll
                for (int q = 0; q < RQ; ++q) { const f32x4* xr = (const f32x4*)(xo + (size_t)(m0 + q) * 1024) + lane; float s = 0.f;
#pragma unroll
                    for (int j = 0; j < 4; ++j) { hv[q][j] = xr[64 * j]; s += (hv[q][j].x * hv[q][j].x + hv[q][j].y * hv[q][j].y) + (hv[q][j].z * hv[q][j].z + hv[q][j].w * hv[q][j].w); }
                    ssq[q] = s; }
#pragma unroll
                for (int o = 1; o < 64; o <<= 1) {
#pragma unroll
                    for (int q = 0; q < RQ; ++q) ssq[q] += __shfl_xor(ssq[q], o); }
#pragma unroll
                for (int j = 0; j < 4; ++j) {
                    const f32x4 gg = ((const f32x4*)g2n)[lane + 64 * j], cc = ((const f32x4*)(mb + 4 * 1024))[lane + 64 * j], hh = ((const f32x4*)(mb + 3 * 1024))[lane + 64 * j];
#pragma unroll
                    for (int q = 0; q < RQ; ++q) { const float rstd = __builtin_amdgcn_rsqf(ssq[q] * (1.f / 1024.f) + EPS);
                        const f32x4 h = hv[q][j] * rstd * gg * (cc + 1.f) + hh; hv[q][j] = h;
                        u32x2 w; w.x = cvt_pk_bf16(h.x, h.y); w.y = cvt_pk_bf16(h.z, h.w); ((u32x2*)(HN + (size_t)(m0 + q) * 1024))[lane + 64 * j] = w; }
                }
                float acc[RQ][16];
#pragma unroll
                for (int e = 0; e < 16; ++e) {
#pragma unroll
                    for (int q = 0; q < RQ; ++q) acc[q][e] = 0.f;
#pragma unroll
                    for (int j = 0; j < 4; ++j) { const f32x4 w = *(const LAS f32x4*)((const LAS char*)wrT + wro + (e * 1028 + 256 * j) * 4);
#pragma unroll
                        for (int q = 0; q < RQ; ++q) acc[q][e] += (hv[q][j].x * w.x + hv[q][j].y * w.y) + (hv[q][j].z * w.z + hv[q][j].w * w.w); }
#pragma unroll
                    for (int q = 0; q < RQ; ++q) asm volatile("" : "+v"(acc[q][e]));
                    __builtin_amdgcn_sched_barrier(0);
                }
#pragma unroll
                for (int q = 0; q < RQ; ++q) {
                    const float tot = tr_reduce16(acc[q], lane);
                    const int e = ((lane >> 5) & 1) * 8 + ((lane >> 4) & 1) * 4 + ((lane >> 3) & 1) * 2 + ((lane >> 2) & 1);
                    if ((lane & 3) == 0) LG[(rl0 + q) * 16 + e] = tot;
                }
            }
            __syncthreads();
            if (tid < RPW) {
                const int rl = tid;
                float sc[16], bz[16];
#pragma unroll
                for (int e4 = 0; e4 < 4; ++e4) { const f32x4 lg = *(const LAS f32x4*)(LG + rl * 16 + 4 * e4);
#pragma unroll
                    for (int k = 0; k < 4; ++k) { sc[4 * e4 + k] = fsigmoid(lg[k]); bz[4 * e4 + k] = sc[4 * e4 + k] + a.router_bias[4 * e4 + k]; } }
                float gs[4];
#pragma unroll
                for (int g = 0; g < 4; ++g) { const float p = bz[4 * g], q = bz[4 * g + 1], r = bz[4 * g + 2], s2 = bz[4 * g + 3];
                    const float h1 = fmaxf(p, q), l1 = fminf(p, q), h2 = fmaxf(r, s2), l2 = fminf(r, s2);
                    gs[g] = fmaxf(h1, h2) + fmaxf(fminf(h1, h2), fmaxf(l1, l2)); }
                int gi = 0; float gb = gs[0];
#pragma unroll
                for (int g = 1; g < 4; ++g) if (gs[g] > gb) { gb = gs[g]; gi = g; }
                float c0 = bz[0], c1 = bz[1], c2 = bz[2], c3 = bz[3], t0 = sc[0], t1 = sc[1], t2 = sc[2], t3 = sc[3];
#pragma unroll
                for (int g = 1; g < 4; ++g) if (gi == g) { c0 = bz[4 * g]; c1 = bz[4 * g + 1]; c2 = bz[4 * g + 2]; c3 = bz[4 * g + 3]; t0 = sc[4 * g]; t1 = sc[4 * g + 1]; t2 = sc[4 * g + 2]; t3 = sc[4 * g + 3]; }
                int i1 = 0; float b1 = c0, s1 = t0;
                if (c1 > b1) { b1 = c1; i1 = 1; s1 = t1; } if (c2 > b1) { b1 = c2; i1 = 2; s1 = t2; } if (c3 > b1) { b1 = c3; i1 = 3; s1 = t3; }
                int i2 = -1; float b2v = -INFINITY, s2 = 0.f;
                if (i1 != 0 && c0 > b2v) { b2v = c0; i2 = 0; s2 = t0; } if (i1 != 1 && c1 > b2v) { b2v = c1; i2 = 1; s2 = t1; }
                if (i1 != 2 && c2 > b2v) { b2v = c2; i2 = 2; s2 = t2; } if (i1 != 3 && c3 > b2v) { b2v = c3; i2 = 3; s2 = t3; }
                if (i2 < 0) { i2 = (i1 == 0) ? 1 : 0; s2 = (i1 == 0) ? t1 : t0; }
                const int e1 = 4 * gi + i1, e2 = 4 * gi + i2; const float inv = 1.f / (s1 + s2);
                const int p1 = atomicAdd((int*)(lcnt + e1), 1), p2 = atomicAdd((int*)(lcnt + e2), 1);
                LAS int* rc = rec + rl * 8; rc[0] = e1; rc[1] = e2; rc[2] = p1; rc[3] = p2; rc[4] = __float_as_int(s1 * inv); rc[5] = __float_as_int(s2 * inv);
            }
            __syncthreads();
            if (tid < 16 && !dry) lcnt[16 + tid] = (int)__hip_atomic_fetch_add(ctl + CW_CNT + (l * 16 + tid) * 64, (unsigned)lcnt[tid], __ATOMIC_RELAXED, __HIP_MEMORY_SCOPE_AGENT);
            __syncthreads();
            if (tid < RPW && !dry) { const LAS int* rc = rec + tid * 8; const int m = bx * RPW + tid; const int e1 = rc[0], e2 = rc[1]; const int p1 = lcnt[16 + e1] + rc[2], p2 = lcnt[16 + e2] + rc[3];
                TL[e1 * T + p1] = m; TL[e2 * T + p2] = m; WL[e1 * T + p1] = __int_as_float(rc[4]); WL[e2 * T + p2] = __int_as_float(rc[5]);
                TS[2 * m] = (e1 << 16) | p1; TS[2 * m + 1] = (e2 << 16) | p2; }
            __syncthreads();
        }
        SEAM(ph); ++ph;
#define MOE_SETUP() do { if (tid == 0) { int cum = 0; \
            _Pragma("unroll") for (int e = 0; e < 16; ++e) { const int cn = (int)__hip_atomic_load(ctl + CW_CNT + (l * 16 + e) * 64, __ATOMIC_RELAXED, __HIP_MEMORY_SCOPE_AGENT); TCUM[32 + e] = cn; TCUM[e] = cum; cum += (cn + 255) >> 8; } \
            TCUM[16] = cum; int n = 0; \
            for (int L = bx; L < cum * 4 && n < 8; L += G, ++n) { const int tile = L >> 2, pn = L & 3; int e = 0; \
                _Pragma("unroll") for (int k = 1; k < 16; ++k) if (tile >= TCUM[k]) e = k; \
                const int rt = tile - TCUM[e]; int nv = TCUM[32 + e] - rt * 256; nv = nv > 256 ? 256 : nv; \
                UL[n * 8 + 0] = tile; UL[n * 8 + 1] = pn; UL[n * 8 + 2] = e; UL[n * 8 + 3] = rt; UL[n * 8 + 4] = nv; } \
            NUN[0] = n; } \
        __syncthreads(); } while (0)
        if (PHEN(9) && IN(ph)) {
            FRESH();
            MOE_SETUP();
            const int nun = __builtin_amdgcn_readfirstlane(NUN[0]);
            pg8::ProbMoeGU P; P.A = (const char*)WSP(bf16_t, WS_HN); P.Bt = (const char*)WSP(bf16_t, WS_WT + WT_GU); P.TL = WSP(int, WS_TL); P.ul = UL; P.nun = nun; P.lda = 1024; P.ldb = 1024; P.K = 1024;
            pg8::EpiGU E{WSP(bf16_t, WS_HE)}; for (int rep = 0; rep < REPS(9); ++rep) pg8::gemm_phase(lds, P, E, tid);
            __syncthreads();
        }
        SEAM(ph); ++ph;
        if (PHEN(11) && IN(ph)) {
            FRESH();
            MOE_SETUP();
            const int nun = __builtin_amdgcn_readfirstlane(NUN[0]);
            pg8::ProbMoeDown P; P.A = (const char*)WSP(bf16_t, WS_HE); P.Bt = (const char*)WSP(bf16_t, WS_WT + WT_DN); P.ul = UL; P.nun = nun; P.lda = 512; P.ldb = 512; P.K = 512;
            pg8::EpiDown E{WSP(bf16_t, WS_Y), WSP(float, WS_WL)}; for (int rep = 0; rep < REPS(11); ++rep) pg8::gemm_phase(lds, P, E, tid);
            __syncthreads();
        }
        SEAM(ph); ++ph;
        if (PHEN(10) && IN(ph)) {
            FRESH();
            const float* mod = WSP(float, WS_MOD); const float* modl = mod + (size_t)l * 4 * 6144; bf16_t* HN = WSP(bf16_t, WS_HN); const bf16_t* Yb = WSP(bf16_t, WS_Y); const int* TS = WSP(int, WS_TS);
            if (tid == 0) { int cum = 0;
#pragma unroll
                for (int e = 0; e < 16; ++e) { const int cn = (int)__hip_atomic_load(ctl + CW_CNT + (l * 16 + e) * 64, __ATOMIC_RELAXED, __HIP_MEMORY_SCOPE_AGENT); TCUM[e] = cum; cum += (cn + 255) >> 8; } }
            __syncthreads();
            for (int rep = 0; rep < REPS(10); ++rep)
            for (int m = gw; m < T; m += NGW) { const bool dry = rep > 0 && hi < 100000;
                const float* mb = modl + (size_t)(m >> 12) * 6144;
                const int t1 = TS[2 * m], t2 = TS[2 * m + 1];
                const size_t r1 = (size_t)TCUM[t1 >> 16] * 256 + (t1 & 0xffff), r2 = (size_t)TCUM[t2 >> 16] * 256 + (t2 & 0xffff);
                float* xr = xo + (size_t)m * 1024;
                f32x4 v[4]; float s = 0.f;
#pragma unroll
                for (int j = 0; j < 4; ++j) {
                    const f32x4 x0 = ((const f32x4*)xr)[lane + 64 * j]; const f32x4 g2 = ((const f32x4*)(mb + 5 * 1024))[lane + 64 * j];
                    const u32x2 y1 = ((const u32x2*)(Yb + r1 * 1024))[lane + 64 * j], y2 = ((const u32x2*)(Yb + r2 * 1024))[lane + 64 * j];
                    const f32x4 ys = (f32x4){bflo(y1.x) + bflo(y2.x), bfhi(y1.x) + bfhi(y2.x), bflo(y1.y) + bflo(y2.y), bfhi(y1.y) + bfhi(y2.y)};
                    v[j] = x0 + g2 * ys;
                    s += (v[j].x * v[j].x + v[j].y * v[j].y) + (v[j].z * v[j].z + v[j].w * v[j].w);
                }
                const float rstd = __builtin_amdgcn_rsqf(wave_sum(s) * (1.f / 1024.f) + EPS);
                if (l + 1 < DEPTH) {
                    const float* mn = mod + ((size_t)(l + 1) * 4 + (m >> 12)) * 6144;
                    u32x2* o8 = (u32x2*)(HN + (size_t)m * 1024) + lane;
                    if (!dry)
#pragma unroll
                    for (int j = 0; j < 4; ++j) { ((f32x4*)xr)[lane + 64 * j] = v[j];
                        const f32x4 gg = ((const f32x4*)(a.norm1_g + (l + 1) * 1024))[lane + 64 * j], cc = ((const f32x4*)(mn + 1024))[lane + 64 * j], hh = ((const f32x4*)mn)[lane + 64 * j];
                        const f32x4 h = v[j] * rstd * gg * (cc + 1.f) + hh; u32x2 w; w.x = cvt_pk_bf16(h.x, h.y); w.y = cvt_pk_bf16(h.z, h.w); o8[64 * j] = w; }
                } else {
                    if (!dry)
#pragma unroll
                    for (int j = 0; j < 4; ++j) { const f32x4 gg = ((const f32x4*)a.final_g)[lane + 64 * j]; ((f32x4*)xr)[lane + 64 * j] = v[j] * rstd * gg; }
                }
            }
            if (l + 1 < DEPTH) { __syncthreads(); conv_weights(a, l + 1, lds, gw, NGW, wave, lane); }
        }
        if (l + 1 < DEPTH) SEAM(ph);
        ++ph;
    }
#undef IN
#undef SEAM
}
constexpr int N_PHASES = 2 + DEPTH * 10;


#ifndef DBG_NAN
#define DBG_NAN 0
#endif
#if DBG_NAN
struct DbgReg { size_t off; size_t n; int f32; };
__global__ void dbg_scan(unsigned char* ws, const float* out) {
    const DbgReg regs[] = {
        {WS_MOD, 2 * 4 * 6144, 1}, {WS_LB, 1024, 1}, {WS_ROPE, (size_t)T * 32, 1}, {WS_SSQKV, (size_t)T * 8, 1}, {WS_SSQQ, (size_t)T * 16, 1}, {WS_AC, 1024 * 128, 1},
        {WS_WT, WT_END / 2, 0}, {WS_HN, (size_t)T * 1024, 0}, {WS_P + P_QH, (size_t)T * 512, 0}, {WS_P + P_LF, (size_t)T * 512, 0}, {WS_P + P_VH, (size_t)T * 512, 0},
        {WS_P + P_HG, (size_t)T * 512, 0}, {WS_P + P_GT, (size_t)T * 2048, 0}, {WS_P + P_CKV, (size_t)T * 256, 0}, {WS_P + P_CQ, (size_t)T * 512, 0}, {WS_P + P_KPE, (size_t)T * 32, 0},
        {WS_Q, (size_t)T * 768, 0}, {WS_KN, (size_t)T * 512, 0}, {WS_V, (size_t)T * 512, 0}, {WS_UT, (size_t)1024 * 128 * 128, 0}};
    unsigned* flags = (unsigned*)(ws + WS_CTL) + 8192;
    const size_t gt = (size_t)blockIdx.x * blockDim.x + threadIdx.x, ng = (size_t)gridDim.x * blockDim.x;
    for (int r = 0; r < 20; ++r) {
        bool bad = false;
        if (regs[r].f32) { const unsigned* p = (const unsigned*)(ws + regs[r].off); for (size_t i = gt; i < regs[r].n; i += ng) bad |= (p[i] & 0x7F800000u) == 0x7F800000u; }
        else { const unsigned short* p = (const unsigned short*)(ws + regs[r].off); for (size_t i = gt; i < regs[r].n; i += ng) bad |= (p[i] & 0x7F80u) == 0x7F80u; }
        if (bad) atomicOr(flags, 1u << r);
    }
    { bool bad = false; const unsigned* p = (const unsigned*)out; for (size_t i = gt; i < (size_t)T * 1024; i += ng) bad |= (p[i] & 0x7F800000u) == 0x7F800000u; if (bad) atomicOr(flags, 1u << 20); }
}
#ifndef DBG_REG
#define DBG_REG 19
#endif
#ifndef DBG_MODE
#define DBG_MODE 0
#endif
__global__ void dbg_stat(unsigned char* ws, size_t off, size_t n, int f32) {
    unsigned* st = (unsigned*)(ws + WS_CTL) + 8200;
    const size_t gt = (size_t)blockIdx.x * blockDim.x + threadIdx.x, ng = (size_t)gridDim.x * blockDim.x;
    unsigned mx = 0, cnt = 0;
    for (size_t i = gt; i < n; i += ng) { unsigned u = f32 ? ((const unsigned*)(ws + off))[i] : ((unsigned)((const unsigned short*)(ws + off))[i] << 16);
        if ((u & 0x7F800000u) == 0x7F800000u) ++cnt; else { u &= 0x7FFFFFFFu; mx = u > mx ? u : mx; } }
    atomicMax(st, mx); if (cnt) atomicAdd(st + 1, cnt);
}
__global__ void dbg_write2(unsigned char* ws, float* out) {
    const unsigned* st = (const unsigned*)(ws + WS_CTL) + 8200;
    const size_t gt = (size_t)blockIdx.x * blockDim.x + threadIdx.x, ng = (size_t)gridDim.x * blockDim.x;
    for (size_t i = gt; i < (size_t)T * 1024; i += ng) out[i] = 0.f;
    if (gt == 0) out[0] = DBG_MODE == 0 ? 1e3f * __uint_as_float(st[0]) : 1e3f + (float)st[1];
}
__global__ void dbg_write(unsigned char* ws, float* out) {
    const unsigned flags = ((const unsigned*)(ws + WS_CTL))[8192];
    const size_t gt = (size_t)blockIdx.x * blockDim.x + threadIdx.x, ng = (size_t)gridDim.x * blockDim.x;
    for (size_t i = gt; i < (size_t)T * 1024; i += ng) out[i] = 0.f;
    if (gt == 0) { float v = 500.f; if (flags) { v = 1000.f; for (int k = 0; k < __builtin_ctz(flags); ++k) v *= 2.f; } out[0] = v; }
}
#endif
extern "C" void kernel_launch(void* const* d_in, const int* in_sizes, int n_in, void* d_out, int out_size, void* d_ws, size_t ws_size, hipStream_t stream) {
    static int ok = 0;
    if (ok == 0) {
        if (n_in != 23 || in_sizes[0] != T * DM || out_size != T * DM || ws_size < WS_END) {
            fprintf(stderr, "kernel_launch: unexpected shapes: n_in %d in0 %d out %d ws %zu (need %zu)\n", n_in, n_in > 0 ? in_sizes[0] : -1, out_size, ws_size, (size_t)WS_END); ok = -1; return; }
        if (hipFuncSetAttribute((const void*)fwd, hipFuncAttributeMaxDynamicSharedMemorySize, LDS_BYTES) != hipSuccess) { fprintf(stderr, "kernel_launch: hipFuncSetAttribute failed\n"); ok = -1; return; }
        int per_cu = 0;
        if (hipOccupancyMaxActiveBlocksPerMultiprocessor(&per_cu, (const void*)fwd, NTHR, LDS_BYTES) != hipSuccess || per_cu < 1)
            fprintf(stderr, "kernel_launch: note: occupancy query reports %d workgroups per CU\n", per_cu);
        (void)hipGetLastError();
        ok = 1;
    }
    if (ok < 0) return;
    (void)hipMemsetAsync((char*)d_ws + WS_CTL, 0, CTL_BYTES, stream);
    Args a{};
    a.x = (const float*)d_in[0]; a.c = (const float*)d_in[1]; a.pos = (const int*)d_in[2]; a.ada_w = (const float*)d_in[3]; a.ada_b = (const float*)d_in[4];
    a.norm1_g = (const float*)d_in[5]; a.w_in = (const float*)d_in[6]; a.lb_logits = (const float*)d_in[7]; a.hg_norm_g = (const float*)d_in[8]; a.q_norm_g = (const float*)d_in[9];
    a.w_q_up = (const float*)d_in[10]; a.kv_norm_g = (const float*)d_in[11]; a.w_kv_up = (const float*)d_in[12]; a.w_br_a = (const float*)d_in[13]; a.w_br_b = (const float*)d_in[14];
    a.w_out = (const float*)d_in[15]; a.norm2_g = (const float*)d_in[16]; a.w_router = (const float*)d_in[17]; a.router_bias = (const float*)d_in[18];
    a.w_gate = (const float*)d_in[19]; a.w_up = (const float*)d_in[20]; a.w_down = (const float*)d_in[21]; a.final_g = (const float*)d_in[22];
    a.out = (float*)d_out; a.ws = (unsigned char*)d_ws;
    const int grid = 256;
#if MK_PER_PHASE
#ifndef MAXPH
#define MAXPH N_PHASES
#endif
    for (int p = 0; p < MAXPH; ++p) { a.ph_lo = p; a.ph_hi = p + 1; hipLaunchKernelGGL(fwd, dim3(grid), dim3(NTHR), LDS_BYTES, stream, a); }
#else
    a.ph_lo = 0; a.ph_hi = N_PHASES; hipLaunchKernelGGL(fwd, dim3(grid), dim3(NTHR), LDS_BYTES, stream, a);
#endif
#if DBG_NAN
    if (DBG_REG < 0) {
    hipLaunchKernelGGL(dbg_scan, dim3(1024), dim3(256), 0, stream, (unsigned char*)d_ws, (const float*)d_out);
    hipLaunchKernelGGL(dbg_write, dim3(1024), dim3(256), 0, stream, (unsigned char*)d_ws, (float*)d_out);
    } else {
    const DbgReg regs[] = {
        {WS_MOD, 2 * 4 * 6144, 1}, {WS_LB, 1024, 1}, {WS_ROPE, (size_t)T * 32, 1}, {WS_SSQKV, (size_t)T * 8, 1}, {WS_SSQQ, (size_t)T * 16, 1}, {WS_AC, 1024 * 128, 1},
        {WS_WT, WT_END / 2, 0}, {WS_HN, (size_t)T * 1024, 0}, {WS_P + P_QH, (size_t)T * 512, 0}, {WS_P + P_LF, (size_t)T * 512, 0}, {WS_P + P_VH, (size_t)T * 512, 0},
        {WS_P + P_HG, (size_t)T * 512, 0}, {WS_P + P_GT, (size_t)T * 2048, 0}, {WS_P + P_CKV, (size_t)T * 256, 0}, {WS_P + P_CQ, (size_t)T * 512, 0}, {WS_P + P_KPE, (size_t)T * 32, 0},
        {WS_Q, (size_t)T * 768, 0}, {WS_KN, (size_t)T * 512, 0}, {WS_V, (size_t)T * 512, 0}, {WS_UT, (size_t)1024 * 128 * 128, 0}};
    const int r = DBG_REG < 0 ? 0 : DBG_REG;
    hipLaunchKernelGGL(dbg_stat, dim3(1024), dim3(256), 0, stream, (unsigned char*)d_ws, regs[r].off, regs[r].n, regs[r].f32);
    hipLaunchKernelGGL(dbg_write2, dim3(1024), dim3(256), 0, stream, (unsigned char*)d_ws, (float*)d_out);
    }
#endif
    const hipError_t le = hipPeekAtLastError();
    if (le != hipSuccess) fprintf(stderr, "kernel_launch: launch failed: %s\n", hipGetErrorName(le));
}
```

```cpp
#include <hip/hip_runtime.h>
#include <cstdio>
#include <cstdint>

#define GAS __attribute__((address_space(1)))
#define LAS __attribute__((address_space(3)))
typedef unsigned short bf16_t;
typedef short bf16x8 __attribute__((ext_vector_type(8)));
typedef short s16x4 __attribute__((ext_vector_type(4)));
typedef float f32x2 __attribute__((ext_vector_type(2)));
typedef float f32x4 __attribute__((ext_vector_type(4)));
typedef float f32x16 __attribute__((ext_vector_type(16)));
typedef unsigned u32x2 __attribute__((ext_vector_type(2)));
typedef unsigned u32x4 __attribute__((ext_vector_type(4)));

#ifndef REP_MASK
#define REP_MASK 0
#endif
#define REPS(k) (1 + (((REP_MASK) >> (k)) & 1))
#ifndef DBG_NOUP
#define DBG_NOUP 0
#endif
#ifndef PH_MASK
#define PH_MASK 0xFFFF
#endif
#define PHEN(k) (((PH_MASK) >> (k)) & 1)
#ifndef MK_PER_PHASE
#define MK_PER_PHASE 0
#endif

constexpr int T = 16384, DM = 1024, NB = 4, SEQ = 4096, DEPTH = 2;
constexpr int NPROJ = 4864, INCOLS = 4768;
constexpr int NE = 16, DE = 512;
constexpr int SLOTROWS = 2 * T + 4096;
constexpr int NWAVES = 8, NTHR = 512;
constexpr float EPS = 1e-6f;

constexpr size_t WS_CTL = 0, CTL_BYTES = 1u << 20;
constexpr size_t WS_MOD = WS_CTL + CTL_BYTES;
constexpr size_t WS_LB = WS_MOD + 2 * 4 * 6144 * 4;
constexpr size_t WS_ROPE = WS_LB + 2 * 512 * 4;
constexpr size_t WS_SSQKV = WS_ROPE + (size_t)T * 16 * 8;
constexpr size_t WS_SSQQ = WS_SSQKV + (size_t)T * 8 * 4;
constexpr size_t WS_AC = WS_SSQQ + (size_t)T * 16 * 4;
constexpr size_t WS_TL = WS_AC + 1024 * 128 * 4;
constexpr size_t WS_WL = WS_TL + (size_t)NE * T * 4;
constexpr size_t WS_TS = WS_WL + (size_t)NE * T * 4;
constexpr size_t WS_WT = WS_TS + (size_t)T * 2 * 4;
constexpr size_t WT_IN = 0, WT_QU = WT_IN + (size_t)NPROJ * 1024 * 2, WT_KV = WT_QU + 768 * 384 * 2, WT_BA = WT_KV + 1024 * 256 * 2,
                 WT_BB = WT_BA + 1024 * 512 * 2, WT_OUT = WT_BB + 1024 * 512 * 2, WT_GU = WT_OUT + 1024 * 1024 * 2,
                 WT_DN = WT_GU + (size_t)NE * 1024 * 1024 * 2, WT_END = WT_DN + (size_t)NE * 1024 * 512 * 2;
constexpr size_t WS_HN = WS_WT + WT_END;
constexpr size_t WS_P = WS_HN + (size_t)T * 1024 * 2;
constexpr size_t P_QH = 0, P_LF = P_QH + (size_t)T * 512 * 2, P_VH = P_LF + (size_t)T * 512 * 2, P_HG = P_VH + (size_t)T * 512 * 2,
                 P_GT = P_HG + (size_t)T * 512 * 2, P_CKV = P_GT + (size_t)T * 2048 * 2, P_CQ = P_CKV + (size_t)T * 256 * 2,
                 P_KPE = P_CQ + (size_t)T * 512 * 2, P_END = P_KPE + (size_t)T * 32 * 2;
constexpr size_t WS_Q = WS_P + P_END;
constexpr size_t WS_KN = WS_Q + (size_t)T * 768 * 2;
constexpr size_t WS_V = WS_KN + (size_t)T * 512 * 2;
constexpr size_t WS_UT = WS_V + (size_t)T * 512 * 2;
constexpr size_t WS_END = WS_UT + (size_t)1024 * 128 * 128 * 2;
constexpr size_t WS_AO = WS_P + P_CQ;
constexpr size_t WS_OA = WS_P + P_LF;
constexpr size_t WS_MG = WS_Q;
constexpr size_t WS_XB = WS_UT;
constexpr size_t WS_TMP = WS_UT;
constexpr size_t WS_HE = WS_P;
constexpr size_t WS_Y = WS_HE + (size_t)SLOTROWS * 512 * 2;
static_assert(WS_Y + (size_t)SLOTROWS * 1024 * 2 <= WS_P + P_END, "MoE overlay fits the projection set");
static_assert((size_t)T * 1024 * 2 <= (size_t)T * 768 * 2 + (size_t)T * 512 * 2, "MG fits Q|KN");
static_assert(WS_END <= 379290688ull, "workspace map exceeds sum(inputs)");
constexpr int CW_BAR = 4096;
constexpr int CW_CNT = 16384;

constexpr int LDS_SCR = 0, LDS_SCR_BYTES = 131072, LDS_MISC = 131072, LDS_BYTES = 147456;

typedef __bf16 bf16x2_t __attribute__((ext_vector_type(2)));
__device__ __forceinline__ unsigned cvt_pk_bf16(float lo, float hi) { f32x2 v = {lo, hi}; bf16x2_t b = __builtin_convertvector(v, bf16x2_t); return __builtin_bit_cast(unsigned, b); }
__device__ __forceinline__ float bf2f(unsigned short h) { return __uint_as_float((unsigned)h << 16); }
__device__ __forceinline__ float bflo(unsigned w) { return __uint_as_float(w << 16); }
__device__ __forceinline__ float bfhi(unsigned w) { return __uint_as_float(w & 0xffff0000u); }
__device__ __forceinline__ float fexp(float x) { return __builtin_amdgcn_exp2f(x * 1.4426950408889634f); }
__device__ __forceinline__ float fsigmoid(float x) { return __builtin_amdgcn_rcpf(1.f + fexp(-x)); }
__device__ __forceinline__ float fsilu(float x) { return x * fsigmoid(x); }
__device__ __forceinline__ float flog(float x) { return __builtin_amdgcn_logf(x) * 0.6931471805599453f; }
__device__ __forceinline__ u32x4 pack8(f32x4 a, f32x4 b) { u32x4 w; w.x = cvt_pk_bf16(a.x, a.y); w.y = cvt_pk_bf16(a.z, a.w); w.z = cvt_pk_bf16(b.x, b.y); w.w = cvt_pk_bf16(b.z, b.w); return w; }
__device__ __forceinline__ void unpack8(u32x4 w, f32x4& a, f32x4& b) { a.x = bflo(w.x); a.y = bfhi(w.x); a.z = bflo(w.y); a.w = bfhi(w.y); b.x = bflo(w.z); b.y = bfhi(w.z); b.z = bflo(w.w); b.w = bfhi(w.w); }
__device__ __forceinline__ float wave_sum(float v) {
#pragma unroll
    for (int o = 1; o < 64; o <<= 1) v += __shfl_xor(v, o);
    return v;
}
#define LDS_WAIT() asm volatile("s_waitcnt lgkmcnt(0)" ::: "memory")
#define VM_WAIT() asm volatile("s_waitcnt vmcnt(0)" ::: "memory")

#define XB_TMO      128
#define XB_XCNT(j)  (256  + 64 * (j))
#define XB_XSUB(j)  (1280 + 64 * (j))
#define XB_XGEN(j)  (2304 + 64 * (j))
#define XB_TOP      3328
#define XB_TOPGEN   3392
#define XCD_BAR_WORDS 3456
#define XB_SPIN_CAP (1u << 18)
__device__ __forceinline__ unsigned xb_ld(unsigned* p)              { return __hip_atomic_load(p, __ATOMIC_RELAXED, __HIP_MEMORY_SCOPE_AGENT); }
__device__ __forceinline__ unsigned xb_add(unsigned* p, unsigned v) { return __hip_atomic_fetch_add(p, v, __ATOMIC_RELAXED, __HIP_MEMORY_SCOPE_AGENT); }
__device__ __forceinline__ unsigned xb_xcc_id() { return (unsigned)__builtin_amdgcn_s_getreg((3 << 11) | 20) & 0xFu; }
#define XB_SPIN(cond, bar) do { unsigned _sp = 0; while (cond) { __builtin_amdgcn_s_sleep(1); \
    if ((++_sp & 255u) == 0u) { if (xb_ld(&(bar)[XB_TMO])) break; if (_sp > XB_SPIN_CAP) { atomicAdd(&(bar)[XB_TMO], 1u); break; } } } } while (0)
struct XcdBarrier { unsigned* bar; unsigned x; volatile LAS unsigned* st; };
__device__ __forceinline__ XcdBarrier xcd_barrier_post(unsigned* bar, volatile LAS unsigned* st) {
    XcdBarrier b; b.bar = bar; b.x = xb_xcc_id(); b.st = st;
    if (threadIdx.x == 0) (void)xb_add(&bar[XB_XCNT(b.x)], 1u);
    return b;
}
__device__ __forceinline__ void xcd_barrier_complete(unsigned* bar, unsigned x, unsigned& nloc, unsigned& nx) {
    const unsigned G = gridDim.x * gridDim.y * gridDim.z;
    unsigned sum, cnt, mine, sp = 0u;
    for (;;) {
        sum = 0u; cnt = 0u; mine = 0u;
#pragma unroll
        for (unsigned j = 0; j < 16; ++j) { const unsigned c = xb_ld(&bar[XB_XCNT(j)]); sum += c; cnt += (c > 0u) ? 1u : 0u; mine = (j == x) ? c : mine; }
        if (sum == G) break;
        __builtin_amdgcn_s_sleep(1);
        if ((++sp & 255u) == 0u) { if (xb_ld(&bar[XB_TMO])) break; if (sp > XB_SPIN_CAP) { atomicAdd(&bar[XB_TMO], 1u); break; } }
    }
    nloc = mine > 0u ? mine : 1u; nx = cnt > 0u ? cnt : 1u;
}
__device__ __forceinline__ void xcd_barrier(const XcdBarrier& b) {
    asm volatile("s_waitcnt vmcnt(0)" ::: "memory");
    __syncthreads();
    if (threadIdx.x == 0) {
        unsigned* bar = b.bar;
        __builtin_amdgcn_s_waitcnt(0);
        unsigned nloc = b.st[0], nx = b.st[1];
        if (nloc == 0u) { xcd_barrier_complete(bar, b.x, nloc, nx); b.st[0] = nloc; b.st[1] = nx; }
        const unsigned old = xb_add(&bar[XB_XSUB(b.x)], 1u);
        const unsigned gen = old / nloc;
        if (old + 1u == (gen + 1u) * nloc) {
            __builtin_amdgcn_fence(__ATOMIC_RELEASE, "agent");
            asm volatile("s_waitcnt vmcnt(0)" ::: "memory");
            const unsigned og = xb_add(&bar[XB_TOP], 1u);
            const unsigned tg = og / nx;
            if (og + 1u == (tg + 1u) * nx) xb_add(&bar[XB_TOPGEN], 1u);
            else XB_SPIN(xb_ld(&bar[XB_TOPGEN]) == tg, bar);
            __builtin_amdgcn_fence(__ATOMIC_ACQUIRE, "agent");
            xb_add(&bar[XB_XGEN(b.x)], 1u);
            asm volatile("s_waitcnt vmcnt(0)" ::: "memory");
        } else {
            XB_SPIN(xb_ld(&bar[XB_XGEN(b.x)]) == gen, bar);
            __builtin_amdgcn_fence(__ATOMIC_ACQUIRE, "agent");
            asm volatile("s_waitcnt vmcnt(0)" ::: "memory");
        }
    }
    __syncthreads();
}

namespace pg8 {
constexpr int BM = 256, BK = 64, HALF = 128, HTB = HALF * BK * 2, STAGE_BYTES = 8 * HTB, NXCD = 8, WGM = 8;
__host__ __device__ __forceinline__ int lds_byte(int r, int c) { const int st = (r >> 4) * 2 + (c >> 5), rr = r & 15, cc = c & 31, ob = rr * 64 + cc * 2; return st * 1024 + (ob ^ (((ob >> 9) & 1) << 5)); }
__host__ __device__ __forceinline__ void stage_rc(int b, int& R, int& C) { const int st = b / 1024, sb = b % 1024, swz = sb ^ (((sb >> 9) & 1) << 5); R = (st >> 1) * 16 + swz / 64; C = (st & 1) * 32 + (swz % 64) / 2; }
__host__ __device__ __forceinline__ int perm32(int rho) { const int n = rho >> 4, i = rho & 15; return 8 * (i >> 2) + 4 * n + (i & 3); }

struct Unit { int pm, pn, e, rt, nv; };

struct StaticOrder {
    int nM, nN, nwg, G, c;
    __device__ __forceinline__ void init(int M, int N, int G_, int c_) { nM = M / BM; nN = N / BM; nwg = nM * nN; G = G_; c = c_; }
    __device__ __forceinline__ bool next(int i, Unit& u) const {
        const long L = (long)i * G + c; if (L >= nwg) return false;
        int wgid = (int)L; { const int q = nwg / NXCD, r = nwg % NXCD, xcd = wgid % NXCD, off = wgid / NXCD; wgid = (xcd < r ? xcd * (q + 1) : r * (q + 1) + (xcd - r) * q) + off; }
        const int nig = WGM * nN, gid = wgid / nig, fm = gid * WGM, gsz = (nM - fm) < WGM ? (nM - fm) : WGM;
        u.pm = fm + ((wgid % nig) % gsz); u.pn = (wgid % nig) / gsz; return true;
    }
};

template <class Epi, class Prob>
__device__ __forceinline__ void gemm_phase(LAS unsigned char* lds, const Prob& P, const Epi& E, const int tid) {
    const int wid = __builtin_amdgcn_readfirstlane(tid >> 6), lane = tid & 63, wr = wid >> 2, wc = wid & 3, fr = lane & 15, fq = lane >> 4;
    const int nt = P.K / BK;
    unsigned voffB[2];
#pragma unroll
    for (int i = 0; i < 2; ++i) { int R, C; stage_rc(tid * 16 + i * 8192, R, C); const int Rb = (R & ~31) + perm32(R & 31); voffB[i] = (unsigned)(Rb * P.ldb + C) * 2u; }
    const size_t kstep = (size_t)(BK * 2);
    const size_t hstepB = (size_t)HALF * P.ldb * 2;
    const unsigned ldsw = (unsigned)wid * 1024u;
    const int aoff = lds_byte(wr * 64 + fr, fq * 8), boff = lds_byte(wc * 32 + fr, fq * 8);
#define PG8_SA(b, h) (((b) * 2 + (h)) * HTB)
#define PG8_SB(b, h) ((4 + (b) * 2 + (h)) * HTB)
#define PG8_STAGE(bufoff, gbase, voff) do { _Pragma("unroll") for (int _i = 0; _i < 2; ++_i) \
        __builtin_amdgcn_global_load_lds((const unsigned*)((const char*)(gbase) + (voff)[_i]), (LAS unsigned*)(lds + (bufoff) + ldsw + _i * 8192), 16, 0, 0); } while (0)
#define PG8_LDA(dst, b, h) do { _Pragma("unroll") for (int m = 0; m < 4; ++m) _Pragma("unroll") for (int k = 0; k < 2; ++k) dst[m][k] = *(const LAS bf16x8*)(lds + PG8_SA(b, h) + aoff + m * 2048 + k * 1024); } while (0)
#define PG8_LDB(dst, b, h) do { _Pragma("unroll") for (int n = 0; n < 2; ++n) _Pragma("unroll") for (int k = 0; k < 2; ++k) dst[n][k] = *(const LAS bf16x8*)(lds + PG8_SB(b, h) + boff + n * 2048 + k * 1024); } while (0)
#define PG8_MMA(ai, bj, At, Bt) do { __builtin_amdgcn_s_setprio(1); _Pragma("unroll") for (int m = 0; m < 4; ++m) _Pragma("unroll") for (int n = 0; n < 2; ++n) _Pragma("unroll") for (int k = 0; k < 2; ++k) \
        acc[ai][bj][m][n] = __builtin_amdgcn_mfma_f32_16x16x32_bf16(Bt[n][k], At[m][k], acc[ai][bj][m][n], 0, 0, 0); __builtin_amdgcn_s_setprio(0); } while (0)
#define PG8_WAIT_V(n) asm volatile("s_waitcnt vmcnt(" #n ")" ::: "memory")
#define PG8_WAIT_L(n) asm volatile("s_waitcnt lgkmcnt(" #n ")" ::: "memory")
#define PG8_BAR __builtin_amdgcn_s_barrier()
#define PG8_SCHED __builtin_amdgcn_sched_barrier(0)
    Unit cur, nxt; int ui = 0;
    if (!P.next(0, cur)) return;
    f32x4 acc[2][2][4][2];
#pragma unroll
    for (int a = 0; a < 2; ++a)
#pragma unroll
        for (int b = 0; b < 2; ++b)
#pragma unroll
            for (int m = 0; m < 4; ++m)
#pragma unroll
                for (int n = 0; n < 2; ++n) acc[a][b][m][n] = (f32x4){0.f, 0.f, 0.f, 0.f};
    bf16x8 At[4][2], B0[2][2], B1[2][2];
    unsigned oc[2][2];
    P.a_off(cur, tid, oc);
    const char* const Ab = P.A;
    const char* cB = P.b_ptr(cur);
    PG8_STAGE(PG8_SB(0, 0), cB, voffB); PG8_STAGE(PG8_SB(0, 1), cB + hstepB, voffB); PG8_STAGE(PG8_SA(0, 0), Ab, oc[0]); PG8_STAGE(PG8_SA(0, 1), Ab, oc[1]);
    if (wr == 1) PG8_BAR;
    PG8_WAIT_V(2); PG8_BAR;
    PG8_STAGE(PG8_SB(1, 0), cB + kstep, voffB); PG8_STAGE(PG8_SA(1, 0), Ab + kstep, oc[0]); PG8_STAGE(PG8_SB(1, 1), cB + hstepB + kstep, voffB);
    PG8_WAIT_V(6); PG8_BAR;
    for (;;) {
        const bool has_next = P.next(ui + 1, nxt);
        const char* nB = has_next ? P.b_ptr(nxt) : cB;
        for (int t = 0; t < nt; t += 2) {
            const bool last = (t == nt - 2);
            if constexpr (Epi::HAS_MID) { if (t == P.ksplit) { __builtin_amdgcn_sched_barrier(0); E.mid(acc, cur, wr, wc, fr, fq); __builtin_amdgcn_sched_barrier(0); } }
            const char* a1; const char* a2;
            if constexpr (Prob::SPLIT) { const int ks = P.ksplit; a1 = (t + 1 < ks) ? Ab + (size_t)(t + 1) * kstep : P.A2 + (size_t)(t + 1 - ks) * kstep;
                a2 = last ? Ab : ((t + 2 < ks) ? Ab + (size_t)(t + 2) * kstep : P.A2 + (size_t)(t + 2 - ks) * kstep); }
            else { a1 = Ab + (size_t)(t + 1) * kstep; a2 = last ? Ab : Ab + (size_t)(t + 2) * kstep; }
            const char* b2 = last ? nB : cB + (size_t)(t + 2) * kstep;
            const char* a3 = a2 + kstep; const char* b3 = b2 + kstep;
            const char* b2h = b2 + hstepB; const char* b3h = b3 + hstepB;
            asm volatile("" : "+s"(a1), "+s"(a2), "+s"(a3));
            asm volatile("" : "+s"(b2), "+s"(b3), "+s"(b2h), "+s"(b3h));
            unsigned o2[2][2];
#pragma unroll
            for (int h = 0; h < 2; ++h)
#pragma unroll
                for (int i = 0; i < 2; ++i) o2[h][i] = oc[h][i];
            if (last && has_next) P.a_off(nxt, tid, o2);
            PG8_LDB(B0, 0, 0); PG8_LDB(B1, 0, 1); PG8_SCHED; PG8_LDA(At, 0, 0); PG8_STAGE(PG8_SA(1, 1), a1, oc[1]);
            PG8_WAIT_V(8); PG8_WAIT_L(0); PG8_BAR; PG8_MMA(0, 0, At, B0); PG8_MMA(0, 1, At, B1); PG8_BAR; PG8_SCHED;
            PG8_LDA(At, 0, 1); PG8_STAGE(PG8_SB(0, 0), b2, voffB); PG8_STAGE(PG8_SB(0, 1), b2h, voffB); PG8_STAGE(PG8_SA(0, 0), a2, o2[0]);
            PG8_WAIT_V(8); PG8_WAIT_L(0); PG8_BAR; PG8_MMA(1, 0, At, B0); PG8_MMA(1, 1, At, B1); PG8_BAR; PG8_SCHED;
            PG8_LDB(B0, 1, 0); PG8_LDB(B1, 1, 1); PG8_SCHED; PG8_LDA(At, 1, 0); PG8_STAGE(PG8_SA(0, 1), a2, o2[1]);
            PG8_WAIT_V(8); PG8_WAIT_L(0); PG8_BAR; PG8_MMA(0, 0, At, B0); PG8_MMA(0, 1, At, B1); PG8_BAR; PG8_SCHED;
            PG8_LDA(At, 1, 1); PG8_STAGE(PG8_SB(1, 0), b3, voffB); PG8_STAGE(PG8_SB(1, 1), b3h, voffB); PG8_STAGE(PG8_SA(1, 0), a3, o2[0]);
            PG8_WAIT_V(8); PG8_WAIT_L(0); PG8_BAR; PG8_MMA(1, 0, At, B0); PG8_MMA(1, 1, At, B1); PG8_BAR; PG8_SCHED;
        }
        if (wr == 0) PG8_BAR;
        E(acc, cur, wr, wc, fr, fq);
        if (!has_next) break;
#pragma unroll
        for (int a = 0; a < 2; ++a)
#pragma unroll
            for (int b = 0; b < 2; ++b)
#pragma unroll
                for (int m = 0; m < 4; ++m)
#pragma unroll
                    for (int n = 0; n < 2; ++n) acc[a][b][m][n] = (f32x4){0.f, 0.f, 0.f, 0.f};
        cur = nxt; cB = nB; ++ui;
        P.a_off(cur, tid, oc);
        if (wr == 1) PG8_BAR;
    }
    PG8_WAIT_V(0);
    PG8_BAR;
#undef PG8_SA
#undef PG8_SB
#undef PG8_STAGE
#undef PG8_LDA
#undef PG8_LDB
#undef PG8_MMA
#undef PG8_WAIT_V
#undef PG8_WAIT_L
#undef PG8_BAR
#undef PG8_SCHED
}

struct ProbDense {
    static constexpr bool SPLIT = false;
    const char* A; const char* Bt; int lda, ldb, K; StaticOrder S;
    __device__ __forceinline__ bool next(int i, Unit& u) const { u.e = 0; u.rt = 0; u.nv = 256; return S.next(i, u); }
    __device__ __forceinline__ void a_off(const Unit& u, int tid, unsigned (&o)[2][2]) const {
#pragma unroll
        for (int i = 0; i < 2; ++i) { int R, C; stage_rc(tid * 16 + i * 8192, R, C);
#pragma unroll
            for (int h = 0; h < 2; ++h) o[h][i] = (unsigned)((u.pm * 256 + h * 128 + R) * lda + C) * 2u; }
    }
    __device__ __forceinline__ const char* b_ptr(const Unit& u) const { return Bt + (size_t)u.pn * 256 * ldb * 2; }
};
struct ProbDenseSplit {
    static constexpr bool SPLIT = true;
    const char* A; const char* A2; const char* Bt; int lda, ldb, K, ksplit; StaticOrder S;
    __device__ __forceinline__ bool next(int i, Unit& u) const { u.e = 0; u.rt = 0; u.nv = 256; return S.next(i, u); }
    __device__ __forceinline__ void a_off(const Unit& u, int tid, unsigned (&o)[2][2]) const {
#pragma unroll
        for (int i = 0; i < 2; ++i) { int R, C; stage_rc(tid * 16 + i * 8192, R, C);
#pragma unroll
            for (int h = 0; h < 2; ++h) o[h][i] = (unsigned)((u.pm * 256 + h * 128 + R) * lda + C) * 2u; }
    }
    __device__ __forceinline__ const char* b_ptr(const Unit& u) const { return Bt + (size_t)u.pn * 256 * ldb * 2; }
};
struct ProbMoeGU {
    static constexpr bool SPLIT = false;
    const char* A; const char* Bt; const int* TL; const LAS int* ul; int nun; int lda, ldb, K;
    __device__ __forceinline__ bool next(int i, Unit& u) const { if (i >= nun) return false; const LAS int* p = ul + i * 8; u.pm = __builtin_amdgcn_readfirstlane(p[0]); u.pn = __builtin_amdgcn_readfirstlane(p[1]); u.e = __builtin_amdgcn_readfirstlane(p[2]); u.rt = __builtin_amdgcn_readfirstlane(p[3]); u.nv = __builtin_amdgcn_readfirstlane(p[4]); return true; }
    __device__ __forceinline__ void a_off(const Unit& u, int tid, unsigned (&o)[2][2]) const {
#pragma unroll
        for (int i = 0; i < 2; ++i) { int R, C; stage_rc(tid * 16 + i * 8192, R, C);
#pragma unroll
            for (int h = 0; h < 2; ++h) { const int idx = h * 128 + R; const int tok = idx < u.nv ? TL[u.e * T + u.rt * 256 + idx] : 0; o[h][i] = (unsigned)(tok * 1024 + C) * 2u; } }
    }
    __device__ __forceinline__ const char* b_ptr(const Unit& u) const { return Bt + ((size_t)u.e * 1024 + (size_t)u.pn * 256) * 1024 * 2; }
};
struct ProbMoeDown {
    static constexpr bool SPLIT = false;
    const char* A; const char* Bt; const LAS int* ul; int nun; int lda, ldb, K;
    __device__ __forceinline__ bool next(int i, Unit& u) const { if (i >= nun) return false; const LAS int* p = ul + i * 8; u.pm = __builtin_amdgcn_readfirstlane(p[0]); u.pn = __builtin_amdgcn_readfirstlane(p[1]); u.e = __builtin_amdgcn_readfirstlane(p[2]); u.rt = __builtin_amdgcn_readfirstlane(p[3]); u.nv = __builtin_amdgcn_readfirstlane(p[4]); return true; }
    __device__ __forceinline__ void a_off(const Unit& u, int tid, unsigned (&o)[2][2]) const {
#pragma unroll
        for (int i = 0; i < 2; ++i) { int R, C; stage_rc(tid * 16 + i * 8192, R, C);
#pragma unroll
            for (int h = 0; h < 2; ++h) o[h][i] = (unsigned)((u.pm * 256 + h * 128 + R) * 512 + C) * 2u; }
    }
    __device__ __forceinline__ const char* b_ptr(const Unit& u) const { return Bt + ((size_t)u.e * 1024 + (size_t)u.pn * 256) * 512 * 2; }
};

#define EPI_ARGS const f32x4 (&acc)[2][2][4][2], const Unit& u, int wr, int wc, int fr, int fq
struct EpiProj {
    static constexpr bool HAS_MID = false;
    bf16_t *QH, *LF, *VH, *HG, *GT, *CKV, *CQ, *KPE; float *SSQKV, *SSQQ; const float* lb; const f32x2* rope;
    __device__ __forceinline__ void operator()(EPI_ARGS) const {
        const int pn = u.pn;
        bf16_t* ob; int ldc, coff, mode;
        if (pn < 8) { const int g = pn >> 1; ob = g == 0 ? QH : g == 1 ? LF : g == 2 ? VH : HG; ldc = 512; coff = (pn & 1) * 256; mode = g == 0 ? 0 : g == 1 ? 1 : g == 2 ? 2 : 3; }
        else if (pn < 16) { ob = GT; ldc = 2048; coff = (pn - 8) * 256; mode = 4; }
        else if (pn == 16) { ob = CKV; ldc = 256; coff = 0; mode = 2; }
        else { ob = CQ; ldc = 512; coff = (pn - 17) * 256; mode = 2; }
#pragma unroll
        for (int ai = 0; ai < 2; ++ai)
#pragma unroll
            for (int m = 0; m < 4; ++m) {
                const int row = u.pm * 256 + ai * 128 + wr * 64 + m * 16 + fr;
#pragma unroll
                for (int bj = 0; bj < 2; ++bj) {
                    const int lc = bj * 128 + wc * 32 + 8 * fq;
                    f32x4 v0 = acc[ai][bj][m][0], v1 = acc[ai][bj][m][1];
                    if (mode == 0) {
#pragma unroll
                        for (int j = 0; j < 4; ++j) { v0[j] = fsilu(v0[j]) * 0.08838834764831845f; v1[j] = fsilu(v1[j]) * 0.08838834764831845f; }
                    } else if (mode == 1) {
                        const f32x4 l0 = *(const f32x4*)(lb + coff + lc), l1 = *(const f32x4*)(lb + coff + lc + 4);
#pragma unroll
                        for (int j = 0; j < 4; ++j) { v0[j] = flog(l0[j] + (1.f - l0[j]) * fsigmoid(v0[j])); v1[j] = flog(l1[j] + (1.f - l1[j]) * fsigmoid(v1[j])); }
                    } else if (mode == 3) {
#pragma unroll
                        for (int j = 0; j < 4; ++j) { v0[j] = fsilu(v0[j]); v1[j] = fsilu(v1[j]); }
                    } else if (mode == 4) {
#pragma unroll
                        for (int j = 0; j < 4; ++j) { v0[j] = fsigmoid(v0[j]); v1[j] = fsigmoid(v1[j]); }
                    }
                    *(u32x4*)(ob + (size_t)row * ldc + coff + lc) = pack8(v0, v1);
                    if (pn >= 16) {
                        float ss = 0.f;
#pragma unroll
                        for (int j = 0; j < 4; ++j) ss += v0[j] * v0[j] + v1[j] * v1[j];
                        ss += __shfl_xor(ss, 16); ss += __shfl_xor(ss, 32);
                        if (fq == 0) {
                            if (pn == 16) SSQKV[(size_t)row * 8 + bj * 4 + wc] = ss;
                            else SSQQ[(size_t)row * 16 + ((pn - 17) * 2 + bj) * 4 + wc] = ss;
                        }
                        if (pn == 18 && bj == 1 && wc == 0) {
                            const f32x2* rp = rope + (size_t)row * 16 + 4 * fq;
                            const f32x2 c0 = rp[0], c1 = rp[1], c2 = rp[2], c3 = rp[3];
                            f32x4 r0, r1;
                            r0.x = v0.x * c0.x - v0.y * c0.y; r0.y = v0.x * c0.y + v0.y * c0.x; r0.z = v0.z * c1.x - v0.w * c1.y; r0.w = v0.z * c1.y + v0.w * c1.x;
                            r1.x = v1.x * c2.x - v1.y * c2.y; r1.y = v1.x * c2.y + v1.y * c2.x; r1.z = v1.z * c3.x - v1.w * c3.y; r1.w = v1.z * c3.y + v1.w * c3.x;
                            *(u32x4*)(KPE + (size_t)row * 32 + 8 * fq) = pack8(r0, r1);
                        }
                    }
                    asm volatile("" ::: "memory");
                }
            }
    }
};
struct EpiQup {
    static constexpr bool HAS_MID = false;
    bf16_t* Q; const float* SSQQ; const f32x2* rope;
    __device__ __forceinline__ void operator()(EPI_ARGS) const {
#pragma unroll
        for (int ai = 0; ai < 2; ++ai)
#pragma unroll
            for (int m = 0; m < 4; ++m) {
                const int row = u.pm * 256 + ai * 128 + wr * 64 + m * 16 + fr;
                const f32x4 s0 = *(const f32x4*)(SSQQ + (size_t)row * 16), s1 = *(const f32x4*)(SSQQ + (size_t)row * 16 + 4), s2 = *(const f32x4*)(SSQQ + (size_t)row * 16 + 8);
                const float ss = ((s0.x + s0.y) + (s0.z + s0.w)) + ((s1.x + s1.y) + (s1.z + s1.w)) + ((s2.x + s2.y) + (s2.z + s2.w));
                const float rstd = __builtin_amdgcn_rsqf(ss * (1.f / 384.f) + EPS);
#pragma unroll
                for (int bj = 0; bj < 2; ++bj) {
                    const int lc = bj * 128 + wc * 32 + 8 * fq;
                    const int g = u.pn * 8 + bj * 4 + wc;
                    f32x4 v0 = acc[ai][bj][m][0] * rstd, v1 = acc[ai][bj][m][1] * rstd;
                    if (g % 3 == 2) {
                        const f32x2* rp = rope + (size_t)row * 16 + 4 * fq;
                        const f32x2 c0 = rp[0], c1 = rp[1], c2 = rp[2], c3 = rp[3];
                        f32x4 r0, r1;
                        r0.x = v0.x * c0.x - v0.y * c0.y; r0.y = v0.x * c0.y + v0.y * c0.x; r0.z = v0.z * c1.x - v0.w * c1.y; r0.w = v0.z * c1.y + v0.w * c1.x;
                        r1.x = v1.x * c2.x - v1.y * c2.y; r1.y = v1.x * c2.y + v1.y * c2.x; r1.z = v1.z * c3.x - v1.w * c3.y; r1.w = v1.z * c3.y + v1.w * c3.x;
                        v0 = r0; v1 = r1;
                    }
                    *(u32x4*)(Q + (size_t)row * 768 + u.pn * 256 + lc) = pack8(v0, v1);
                    asm volatile("" ::: "memory");
                }
            }
    }
};
struct EpiKVup {
    static constexpr bool HAS_MID = false;
    bf16_t *KN, *V; const float* SSQKV;
    __device__ __forceinline__ void operator()(EPI_ARGS) const {
        bf16_t* ob = u.pn < 2 ? KN : V; const int coff = (u.pn & 1) * 256;
#pragma unroll
        for (int ai = 0; ai < 2; ++ai)
#pragma unroll
            for (int m = 0; m < 4; ++m) {
                const int row = u.pm * 256 + ai * 128 + wr * 64 + m * 16 + fr;
                const f32x4 s0 = *(const f32x4*)(SSQKV + (size_t)row * 8), s1 = *(const f32x4*)(SSQKV + (size_t)row * 8 + 4);
                const float ss = ((s0.x + s0.y) + (s0.z + s0.w)) + ((s1.x + s1.y) + (s1.z + s1.w));
                const float rstd = __builtin_amdgcn_rsqf(ss * (1.f / 256.f) + EPS);
#pragma unroll
                for (int bj = 0; bj < 2; ++bj) {
                    const int lc = bj * 128 + wc * 32 + 8 * fq;
                    *(u32x4*)(ob + (size_t)row * 512 + coff + lc) = pack8(acc[ai][bj][m][0] * rstd, acc[ai][bj][m][1] * rstd);
                }
                asm volatile("" ::: "memory");
            }
    }
};
struct EpiBr1 {
    static constexpr bool HAS_MID = false;
    bf16_t* O; const bf16_t* GT;
    __device__ __forceinline__ void operator()(EPI_ARGS) const {
#pragma unroll
        for (int ai = 0; ai < 2; ++ai)
#pragma unroll
            for (int m = 0; m < 4; ++m) {
                const int row = u.pm * 256 + ai * 128 + wr * 64 + m * 16 + fr;
#pragma unroll
                for (int bj = 0; bj < 2; ++bj) {
                    const int col = u.pn * 256 + bj * 128 + wc * 32 + 8 * fq;
                    f32x4 g0, g1; unpack8(*(const u32x4*)(GT + (size_t)row * 2048 + col), g0, g1);
                    *(u32x4*)(O + (size_t)row * 1024 + col) = pack8(acc[ai][bj][m][0] * g0, acc[ai][bj][m][1] * g1);
                }
                asm volatile("" ::: "memory");
            }
    }
};
struct EpiBr2 {
    static constexpr bool HAS_MID = false;
    bf16_t* O; const bf16_t* TMP; const bf16_t* GT;
    __device__ __forceinline__ void operator()(EPI_ARGS) const {
#pragma unroll
        for (int ai = 0; ai < 2; ++ai)
#pragma unroll
            for (int m = 0; m < 4; ++m) {
                const int row = u.pm * 256 + ai * 128 + wr * 64 + m * 16 + fr;
#pragma unroll
                for (int bj = 0; bj < 2; ++bj) {
                    const int col = u.pn * 256 + bj * 128 + wc * 32 + 8 * fq;
                    f32x4 g0, g1, t0, t1; unpack8(*(const u32x4*)(GT + (size_t)row * 2048 + 1024 + col), g0, g1); unpack8(*(const u32x4*)(TMP + (size_t)row * 1024 + col), t0, t1);
                    *(u32x4*)(O + (size_t)row * 1024 + col) = pack8(t0 + acc[ai][bj][m][0] * g0, t1 + acc[ai][bj][m][1] * g1);
                    asm volatile("" ::: "memory");
                }
            }
    }
};
struct EpiBr {
    static constexpr bool HAS_MID = true;
    bf16_t* O; const bf16_t* GT;
    __device__ __forceinline__ void mid(f32x4 (&acc)[2][2][4][2], const Unit& u, int wr, int wc, int fr, int fq) const {
        asm volatile("" : "+v"(fr), "+v"(fq)); const bf16_t* G0 = GT;
#pragma unroll
        for (int ai2 = 0; ai2 < 4; ++ai2) { const int ai = ai2 >> 1, mb = (ai2 & 1) * 2;
            u32x4 ga[4][2], gb[4][2];
#pragma unroll
            for (int m = mb; m < mb + 2; ++m) { const int row = u.pm * 256 + ai * 128 + wr * 64 + m * 16 + fr;
#pragma unroll
                for (int bj = 0; bj < 2; ++bj) { const int col = u.pn * 256 + bj * 128 + wc * 32 + 8 * fq;
                    ga[m][bj] = *(const u32x4*)(G0 + (size_t)row * 2048 + col); gb[m][bj] = *(const u32x4*)(G0 + (size_t)row * 2048 + 1024 + col); } }
#pragma unroll
            for (int m = mb; m < mb + 2; ++m)
#pragma unroll
                for (int bj = 0; bj < 2; ++bj) { f32x4 a0, a1, b0, b1; unpack8(ga[m][bj], a0, a1); unpack8(gb[m][bj], b0, b1);
#pragma unroll
                    for (int j = 0; j < 4; ++j) { acc[ai][bj][m][0][j] *= a0[j] * __builtin_amdgcn_rcpf(b0[j]); acc[ai][bj][m][1][j] *= a1[j] * __builtin_amdgcn_rcpf(b1[j]); } }
            asm volatile("" ::: "memory");
        }
    }
    __device__ __forceinline__ void operator()(EPI_ARGS) const {
#pragma unroll
        for (int ai = 0; ai < 2; ++ai)
#pragma unroll
            for (int m = 0; m < 4; ++m) {
                const int row = u.pm * 256 + ai * 128 + wr * 64 + m * 16 + fr;
#pragma unroll
                for (int bj = 0; bj < 2; ++bj) {
                    const int col = u.pn * 256 + bj * 128 + wc * 32 + 8 * fq;
                    f32x4 g0, g1; unpack8(*(const u32x4*)(GT + (size_t)row * 2048 + 1024 + col), g0, g1);
                    *(u32x4*)(O + (size_t)row * 1024 + col) = pack8(acc[ai][bj][m][0] * g0, acc[ai][bj][m][1] * g1);
                }
                asm volatile("" ::: "memory");
            }
    }
};
struct EpiOut {
    static constexpr bool HAS_MID = false;
    const float* xin; const bf16_t* xinb; bf16_t* xout; const float* g1; int dry;
    __device__ __forceinline__ void operator()(EPI_ARGS) const {
#pragma unroll
        for (int ai = 0; ai < 2; ++ai)
#pragma unroll
            for (int m = 0; m < 4; ++m) {
                const int row = u.pm * 256 + ai * 128 + wr * 64 + m * 16 + fr;
                const float* gp = g1 + (size_t)(row >> 12) * 6144;
#pragma unroll
                for (int bj = 0; bj < 2; ++bj) {
                    const int col = u.pn * 256 + bj * 128 + wc * 32 + 8 * fq;
                    const size_t o = (size_t)row * 1024 + col;
                    f32x4 x0, x1;
                    if (xin) { x0 = *(const f32x4*)(xin + o); x1 = *(const f32x4*)(xin + o + 4); } else unpack8(*(const u32x4*)(xinb + o), x0, x1);
                    const f32x4 ga = *(const f32x4*)(gp + col), gb = *(const f32x4*)(gp + col + 4);
                    if (!dry) *(u32x4*)(xout + o) = pack8(x0 + ga * acc[ai][bj][m][0], x1 + gb * acc[ai][bj][m][1]);
                    asm volatile("" ::: "memory");
                }
            }
    }
};
struct EpiGU {
    static constexpr bool HAS_MID = false;
    bf16_t* HE;
    __device__ __forceinline__ void operator()(EPI_ARGS) const {
#pragma unroll
        for (int ai = 0; ai < 2; ++ai)
#pragma unroll
            for (int m = 0; m < 4; ++m) {
                const int row = u.pm * 256 + ai * 128 + wr * 64 + m * 16 + fr;
                f32x4 g0 = acc[ai][0][m][0], g1 = acc[ai][0][m][1];
                const f32x4 u0 = acc[ai][1][m][0], u1 = acc[ai][1][m][1];
#pragma unroll
                for (int j = 0; j < 4; ++j) { g0[j] = fsilu(g0[j]) * u0[j]; g1[j] = fsilu(g1[j]) * u1[j]; }
                *(u32x4*)(HE + (size_t)row * 512 + u.pn * 128 + wc * 32 + 8 * fq) = pack8(g0, g1);
            }
    }
};
struct EpiDown {
    static constexpr bool HAS_MID = false;
    bf16_t* Y; const float* WL;
    __device__ __forceinline__ void operator()(EPI_ARGS) const {
#pragma unroll
        for (int ai = 0; ai < 2; ++ai)
#pragma unroll
            for (int m = 0; m < 4; ++m) {
                const int idx = ai * 128 + wr * 64 + m * 16 + fr;
                const int row = u.pm * 256 + idx;
                const float w = idx < u.nv ? WL[u.e * T + u.rt * 256 + idx] : 0.f;
#pragma unroll
                for (int bj = 0; bj < 2; ++bj) {
                    const int col = u.pn * 256 + bj * 128 + wc * 32 + 8 * fq;
                    *(u32x4*)(Y + (size_t)row * 1024 + col) = pack8(acc[ai][bj][m][0] * w, acc[ai][bj][m][1] * w);
                }
            }
    }
};
}

namespace att {
constexpr int NW = 8, QBLK = 32, KVBLK = 64;
constexpr float SCALE = 0.10206207261596575f;
constexpr float THR = 8.f;
constexpr int SHM_V = 8192, SHM_K = 16384;
constexpr int OFF_V = 0, OFF_K = 2 * SHM_V, OFF_WS = OFF_K + 2 * SHM_K;
#define KSWZ(row, colB) ((row) * 256 + ((colB) ^ (((row) & 7) << 4)))
#define SBAR() __builtin_amdgcn_sched_barrier(0)
__device__ __forceinline__ int crow(int r, int hi) { return (r & 3) + 8 * (r >> 2) + 4 * hi; }
__device__ __forceinline__ unsigned cvtpk(float lo, float hi) { return cvt_pk_bf16(lo, hi); }
__device__ __forceinline__ void partialSM(f32x16& p0, f32x16& p1, float& m_reg, float& mn, float& alpha) {
  constexpr float C = SCALE * 1.4426950408889634f;
  float pmax = p0[0];
#pragma unroll
  for (int r = 1; r < 16; ++r) pmax = fmaxf(pmax, p0[r]);
#pragma unroll
  for (int r = 0; r < 16; ++r) pmax = fmaxf(pmax, p1[r]);
  { auto rr = __builtin_amdgcn_permlane32_swap(__float_as_uint(pmax), __float_as_uint(pmax), false, false);
    pmax = fmaxf(__uint_as_float(rr[0]), __uint_as_float(rr[1])); }
  if (__builtin_expect(__all(pmax - m_reg <= THR / SCALE), 1)) { mn = m_reg; alpha = 1.f; }
  else { mn = fmaxf(m_reg, pmax); alpha = __builtin_amdgcn_exp2f((m_reg - mn) * C); m_reg = mn; }
  float mnC = -mn * C;
#pragma unroll
  for (int r = 0; r < 16; ++r) p0[r] = fmaf(p0[r], C, mnC);
#pragma unroll
  for (int r = 0; r < 16; ++r) p1[r] = fmaf(p1[r], C, mnC);
#pragma unroll
  for (int r = 0; r < 16; ++r) p0[r] = __builtin_amdgcn_exp2f(p0[r]);
}
__device__ __forceinline__ void finishSM(f32x16& p0, f32x16& p1, float alpha, float& l_reg, bf16x8& pa0, bf16x8& pa1, bf16x8& pa2, bf16x8& pa3) {
#pragma unroll
  for (int r = 0; r < 16; ++r) p1[r] = __builtin_amdgcn_exp2f(p1[r]);
  float ps = 0;
#pragma unroll
  for (int r = 0; r < 16; ++r) ps += p0[r];
#pragma unroll
  for (int r = 0; r < 16; ++r) ps += p1[r];
  { auto rr = __builtin_amdgcn_permlane32_swap(__float_as_uint(ps), __float_as_uint(ps), false, false);
    ps = __uint_as_float(rr[0]) + __uint_as_float(rr[1]); }
  l_reg = l_reg * alpha + ps;
#define PK4(P, BASE, OUT) do { unsigned a0 = cvtpk(P[BASE + 0], P[BASE + 1]), a1 = cvtpk(P[BASE + 2], P[BASE + 3]);   \
    unsigned b0 = cvtpk(P[BASE + 4], P[BASE + 5]), b1 = cvtpk(P[BASE + 6], P[BASE + 7]);                              \
    auto r0 = __builtin_amdgcn_permlane32_swap(a0, b0, false, false); auto r1 = __builtin_amdgcn_permlane32_swap(a1, b1, false, false); \
    u32x4 w = {r0[0], r1[0], r0[1], r1[1]}; OUT = __builtin_bit_cast(bf16x8, w); } while (0)
  PK4(p0, 0, pa0); PK4(p0, 8, pa1); PK4(p1, 0, pa2); PK4(p1, 8, pa3);
#undef PK4
}
__device__ __forceinline__ void qkt(f32x16& p0, f32x16& p1, const LAS char* Ks, const bf16x8* qr, int r32, int hi) {
  p0 = f32x16{}; p1 = f32x16{};
#pragma unroll
  for (int d0 = 0; d0 < 6; ++d0) { const int cb = (d0 * 16 + hi * 8) * 2;
    const bf16x8 b0 = *(const LAS bf16x8*)(Ks + KSWZ(r32, cb));
    const bf16x8 b1 = *(const LAS bf16x8*)(Ks + KSWZ(32 + r32, cb));
    p0 = __builtin_amdgcn_mfma_f32_32x32x16_bf16(b0, qr[d0], p0, 0, 0, 0);
    p1 = __builtin_amdgcn_mfma_f32_32x32x16_bf16(b1, qr[d0], p1, 0, 0, 0); }
}
__device__ __forceinline__ int v_st(int k, int c) { const int kk = (k & ~0xC) | ((k & 4) << 1) | ((k & 8) >> 1); return ((kk >> 3) * 2 + (c >> 5)) * 512 + ((kk & 7) * 32 + (c & 31)) * 2; }
__device__ __forceinline__ int v_rd_base(int lane) { return ((lane & 3) << 3) | (((lane >> 2) & 3) << 6) | (((lane >> 4) & 1) << 5) | (((lane >> 5) & 1) << 8); }
constexpr int v_rd_off(int d0, int ks, int half) { return d0 * 512 + ks * 2048 + half * 1024; }
template <int OFF> __device__ __forceinline__ s16x4 tr_read(int vb) {
  s16x4 r; asm volatile("ds_read_b64_tr_b16 %0, %1 offset:%2" : "=&v"(r) : "v"(vb), "i"(OFF) : "memory"); return r;
}
template <int D0> __device__ __forceinline__ void pv_one(f32x16& od, int vb, bf16x8 pa0, bf16x8 pa1, bf16x8 pa2, bf16x8 pa3) {
  const s16x4 l0 = tr_read<v_rd_off(D0, 0, 0)>(vb), h0 = tr_read<v_rd_off(D0, 0, 1)>(vb), l1 = tr_read<v_rd_off(D0, 1, 0)>(vb), h1 = tr_read<v_rd_off(D0, 1, 1)>(vb);
  const s16x4 l2 = tr_read<v_rd_off(D0, 2, 0)>(vb), h2 = tr_read<v_rd_off(D0, 2, 1)>(vb), l3 = tr_read<v_rd_off(D0, 3, 0)>(vb), h3 = tr_read<v_rd_off(D0, 3, 1)>(vb);
  asm volatile("s_waitcnt lgkmcnt(0)" ::: "memory"); SBAR();
#define PK(L, H) (bf16x8){L[0], L[1], L[2], L[3], H[0], H[1], H[2], H[3]}
  od = __builtin_amdgcn_mfma_f32_32x32x16_bf16(pa0, PK(l0, h0), od, 0, 0, 0);
  od = __builtin_amdgcn_mfma_f32_32x32x16_bf16(pa1, PK(l1, h1), od, 0, 0, 0);
  od = __builtin_amdgcn_mfma_f32_32x32x16_bf16(pa2, PK(l2, h2), od, 0, 0, 0);
  od = __builtin_amdgcn_mfma_f32_32x32x16_bf16(pa3, PK(l3, h3), od, 0, 0, 0);
#undef PK
}
__device__ __forceinline__ void pv_d0(f32x16* o, int vb, bf16x8 pa0, bf16x8 pa1, bf16x8 pa2, bf16x8 pa3) {
  pv_one<0>(o[0], vb, pa0, pa1, pa2, pa3); pv_one<1>(o[1], vb, pa0, pa1, pa2, pa3);
}
__device__ __forceinline__ void maskfill(f32x16& p0, f32x16& p1) {
#pragma unroll
  for (int r = 0; r < 16; ++r) { p0[r] = -1e30f; p1[r] = -1e30f; }
}
__device__ __forceinline__ void attn_unit(int b, int h, int qb, const bf16_t* __restrict__ Q, const bf16_t* __restrict__ KN, const bf16_t* __restrict__ KPE,
                                          const bf16_t* __restrict__ V, bf16_t* __restrict__ AO, LAS char* lds, const int tid) {
  const int wid = tid >> 6, lane = tid & 63, r32 = lane & 31, hi = lane >> 5;
  LAS char* V_lds = lds + OFF_V; LAS char* K_lds = lds + OFF_K;
  LAS float* ws = (LAS float*)(lds + OFF_WS) + wid * 64; LAS float* li_l = ws; LAS float* al_l = ws + 32;
  const long rowbase = (long)b * SEQ; const int q0 = qb * 256;
  float m_reg = -1e30f, l_reg = 0; f32x16 o[2] = {}; bf16x8 qr[6];
  const bf16_t* Qw = Q + (rowbase + q0 + wid * QBLK + r32) * 768 + h * 96 + hi * 8;
#pragma unroll
  for (int d0 = 0; d0 < 6; ++d0) qr[d0] = *(const bf16x8*)(Qw + d0 * 16);
  const int sr = tid >> 3, sc = (tid & 7) * 8, srp = (tid >> 2) & 63, scp = (tid & 3) * 8;
  const bool hasp = tid < 256;
  const int vst0 = v_st(sr, sc);
  const int vb0 = (int)(unsigned)(uintptr_t)V_lds + v_rd_base(lane);
  const bf16_t* Kg = KN + rowbase * 512 + h * 64 + (long)sr * 512 + sc;
  const bf16_t* Vg = V + rowbase * 512 + h * 64 + (long)sr * 512 + sc;
  const bf16_t* Pg = KPE + rowbase * 32 + (long)srp * 32 + scp;
  bf16x8 vs0, ks0, kp0 = {};
#define SLOAD(k0) do { vs0 = *(const bf16x8*)(Vg + (long)(k0) * 512); ks0 = *(const bf16x8*)(Kg + (long)(k0) * 512); if (hasp) kp0 = *(const bf16x8*)(Pg + (long)(k0) * 32); } while (0)
#define SWRITE(bb) do { *(LAS bf16x8*)(V_lds + (bb) * SHM_V + vst0) = vs0; *(LAS bf16x8*)(K_lds + (bb) * SHM_K + KSWZ(sr, sc * 2)) = ks0; \
    if (hasp) *(LAS bf16x8*)(K_lds + (bb) * SHM_K + KSWZ(srp, (64 + scp) * 2)) = kp0; } while (0)
#define SWAIT() asm volatile("s_waitcnt vmcnt(0)" ::: "memory")
#define RESC(a) do { if (__any((a) < 1.f)) { if (hi == 0) al_l[r32] = (a); asm volatile("s_waitcnt lgkmcnt(0)" ::: "memory"); \
    _Pragma("unroll") for (int d = 0; d < 2; ++d) _Pragma("unroll") for (int r = 0; r < 16; ++r) o[d][r] *= al_l[crow(r, hi)]; } } while (0)
  const int NT = q0 / KVBLK + 4; const int vis = q0 / KVBLK + (wid >> 1);
#define MASK(P0, P1, t) do { if ((t) > vis) maskfill(P0, P1); } while (0)
  f32x16 pA0, pA1, pB0, pB1; float mnA, mnB, alA, alB; bf16x8 pa0, pa1, pa2, pa3;
  SLOAD(0); SWAIT(); SWRITE(0); __syncthreads();
  qkt(pA0, pA1, K_lds, qr, r32, hi); partialSM(pA0, pA1, m_reg, mnA, alA);
  SLOAD(KVBLK);
  SWAIT(); SWRITE(1); __syncthreads();
  for (int j = 1; j + 1 < NT; j += 2) {
    SBAR(); qkt(pB0, pB1, K_lds + SHM_K, qr, r32, hi); MASK(pB0, pB1, j);
    finishSM(pA0, pA1, alA, l_reg, pa0, pa1, pa2, pa3); SBAR();
    SLOAD((j + 1) * KVBLK); SBAR();
    pv_d0(o, vb0, pa0, pa1, pa2, pa3); partialSM(pB0, pB1, m_reg, mnB, alB);
    __syncthreads(); SWAIT(); SWRITE(0);
    RESC(alB); __syncthreads();
    SBAR(); qkt(pA0, pA1, K_lds, qr, r32, hi); MASK(pA0, pA1, j + 1);
    finishSM(pB0, pB1, alB, l_reg, pa0, pa1, pa2, pa3); SBAR();
    SLOAD((j + 2) * KVBLK); SBAR();
    pv_d0(o, vb0 + SHM_V, pa0, pa1, pa2, pa3); partialSM(pA0, pA1, m_reg, mnA, alA);
    __syncthreads(); SWAIT(); SWRITE(1);
    RESC(alA); __syncthreads();
  }
  SBAR(); qkt(pB0, pB1, K_lds + SHM_K, qr, r32, hi); MASK(pB0, pB1, NT - 1);
  finishSM(pA0, pA1, alA, l_reg, pa0, pa1, pa2, pa3); SBAR();
  pv_d0(o, vb0, pa0, pa1, pa2, pa3); partialSM(pB0, pB1, m_reg, mnB, alB);
  __syncthreads(); RESC(alB);
  finishSM(pB0, pB1, alB, l_reg, pa0, pa1, pa2, pa3); SBAR();
  pv_d0(o, vb0 + SHM_V, pa0, pa1, pa2, pa3);
  if (hi == 0) li_l[r32] = l_reg; asm volatile("s_waitcnt lgkmcnt(0)" ::: "memory");
  float rli[16];
#pragma unroll
  for (int r = 0; r < 16; ++r) rli[r] = __builtin_amdgcn_rcpf(li_l[crow(r, hi)]);
  bf16_t* Ow = AO + (rowbase + q0 + wid * QBLK) * 512 + h * 64;
#pragma unroll
  for (int r = 0; r < 16; ++r) { const int orow = crow(r, hi);
#pragma unroll
    for (int d0 = 0; d0 < 2; ++d0) Ow[(long)orow * 512 + d0 * 32 + r32] = (bf16_t)(cvtpk(o[d0][r] * rli[r], 0.f) & 0xffffu); }
  __syncthreads();
#undef SLOAD
#undef SWRITE
#undef SWAIT
#undef RESC
#undef MASK
}
#undef SBAR
}

struct Args {
    const float* x; const float* c; const int* pos; const float* ada_w; const float* ada_b; const float* norm1_g; const float* w_in; const float* lb_logits;
    const float* hg_norm_g; const float* q_norm_g; const float* w_q_up; const float* kv_norm_g; const float* w_kv_up; const float* w_br_a; const float* w_br_b;
    const float* w_out; const float* norm2_g; const float* w_router; const float* router_bias; const float* w_gate; const float* w_up; const float* w_down; const float* final_g;
    float* out; unsigned char* ws; int ph_lo, ph_hi;
};

__device__ __forceinline__ void tr_item(const float* src, int srcN, int sn0, bf16_t* dst, int dK, int dr0, int k0, const float* rs, bool il, bool zero, LAS float* scr, int lane) {
    if (!zero) {
        f32x4 v[8];
#pragma unroll
        for (int r = 0; r < 8; ++r) { const int kk = (lane >> 3) + 8 * r; v[r] = *(const f32x4*)(src + (size_t)(k0 + kk) * srcN + sn0 + (lane & 7) * 4); }
#pragma unroll
        for (int r = 0; r < 8; ++r) { const int kk = (lane >> 3) + 8 * r; f32x4 x = v[r]; if (rs) x = x * rs[k0 + kk];
            LAS float* d = scr + kk * 33 + (lane & 7) * 4; d[0] = x.x; d[1] = x.y; d[2] = x.z; d[3] = x.w; }
    }
    LDS_WAIT(); asm volatile("" ::: "memory");
    const int c = lane & 7;
#pragma unroll
    for (int j = 0; j < 4; ++j) {
        const int n = (lane >> 3) + 8 * j; const int sn = il ? ((n & 1) ? 16 + (n >> 1) : (n >> 1)) : n;
        const LAS float* s = scr + (8 * c) * 33 + sn;
        u32x4 o;
        if (zero) { unsigned z = 0u; asm volatile("" : "+v"(z)); o = (u32x4){z, z, z, z}; }
        else { o.x = cvt_pk_bf16(s[0 * 33], s[1 * 33]); o.y = cvt_pk_bf16(s[2 * 33], s[3 * 33]); o.z = cvt_pk_bf16(s[4 * 33], s[5 * 33]); o.w = cvt_pk_bf16(s[6 * 33], s[7 * 33]); }
        *(u32x4*)(dst + (size_t)(dr0 + n) * dK + k0 + 8 * c) = o;
    }
    LDS_WAIT(); asm volatile("" ::: "memory");
}
__device__ __forceinline__ void conv_weights(const Args& a, int l, LAS unsigned char* lds, int gw, int NGW, int wave, int lane) {
    LAS float* scr = (LAS float*)(lds + wave * 16384);
    bf16_t* WT = (bf16_t*)(a.ws + WS_WT);
    constexpr int I_IN = 16 * 152, I_QU = 6 * 24, I_KV = 4 * 32, I_BR = 8 * 32, I_OUT = 16 * 32, I_GU = NE * 16 * 32, I_DN = NE * 8 * 32;
    constexpr int NIT = I_IN + I_QU + I_KV + 2 * I_BR + I_OUT + I_GU + I_DN;
    for (int it = gw; it < NIT; it += NGW) {
        int r = it;
        if (r < I_IN) { const int kb = r / 152, db = r % 152; int sn0; bool il = false, zero = false;
            if (db < 64) sn0 = 32 * db; else if (db < 128) sn0 = 2720 + 32 * (db - 64); else if (db < 136) sn0 = 2432 + 32 * (db - 128); else if (db < 148) sn0 = 2048 + 32 * (db - 136);
            else if (db == 148) { sn0 = 2688; il = true; } else { sn0 = 0; zero = true; }
            tr_item(a.w_in + (size_t)l * 1024 * INCOLS, INCOLS, sn0, WT + WT_IN / 2, 1024, 32 * db, 64 * kb, nullptr, il, zero, scr, lane); continue; }
        r -= I_IN;
        if (r < I_QU) { const int kb = r / 24, db = r % 24;
            tr_item(a.w_q_up + (size_t)l * 384 * 768, 768, 32 * db, WT + WT_QU / 2, 384, 32 * db, 64 * kb, a.q_norm_g + l * 384, (db % 3) == 2, false, scr, lane); continue; }
        r -= I_QU;
        if (r < I_KV) { const int kb = r / 32, db = r % 32; const int hh = (db & 15) >> 1, half = db & 1; const int sn0 = hh * 128 + (db >= 16 ? 64 : 0) + 32 * half;
            tr_item(a.w_kv_up + (size_t)l * 256 * 1024, 1024, sn0, WT + WT_KV / 2, 256, 32 * db, 64 * kb, a.kv_norm_g + l * 256, false, false, scr, lane); continue; }
        r -= I_KV;
        if (r < I_BR) { const int kb = r / 32, db = r % 32; tr_item(a.w_br_a + (size_t)l * 512 * 1024, 1024, 32 * db, WT + WT_BA / 2, 1024, 32 * db, 64 * kb, nullptr, false, false, scr, lane); continue; }
        r -= I_BR;
        if (r < I_BR) { const int kb = r / 32, db = r % 32; tr_item(a.w_br_b + (size_t)l * 512 * 1024, 1024, 32 * db, WT + WT_BA / 2 + 512, 1024, 32 * db, 64 * kb, nullptr, false, false, scr, lane); continue; }
        r -= I_BR;
        if (r < I_OUT) { const int kb = r / 32, db = r % 32; tr_item(a.w_out + (size_t)l * 1024 * 1024, 1024, 32 * db, WT + WT_OUT / 2, 1024, 32 * db, 64 * kb, nullptr, false, false, scr, lane); continue; }
        r -= I_OUT;
        if (r < I_GU) { const int e = r / 512, q = r % 512, kb = q / 32, db = q % 32; const int pn = db >> 3, rr = db & 7;
            const float* src = (rr < 4 ? a.w_gate : a.w_up) + ((size_t)l * NE + e) * 1024 * 512;
            tr_item(src, 512, 128 * pn + 32 * (rr & 3), WT + WT_GU / 2 + (size_t)e * 1024 * 1024, 1024, 32 * db, 64 * kb, nullptr, false, false, scr, lane); continue; }
        r -= I_GU;
        { const int e = r / 256, q = r % 256, kb = q / 32, db = q % 32;
            tr_item(a.w_down + ((size_t)l * NE + e) * 512 * 1024, 1024, 32 * db, WT + WT_DN / 2 + (size_t)e * 1024 * 512, 512, 32 * db, 64 * kb, nullptr, false, false, scr, lane); }
    }
}
__device__ __forceinline__ void mod_phase(const Args& a, LAS unsigned char* lds, int tid, int wave, int lane) {
    LAS float* ca = (LAS float*)lds;
    LAS float* red = (LAS float*)(lds + 16384);
    float* mod = (float*)(a.ws + WS_MOD);
    for (int i = tid; i < 4096; i += NTHR) ca[i] = fsilu(a.c[i]);
    __syncthreads();
    for (int u = blockIdx.x; u < 192; u += gridDim.x) {
        const int l = u / 96, n0 = (u % 96) * 64;
        const float* W = a.ada_w + (size_t)l * 1024 * 6144 + n0 + lane;
        float s0 = 0.f, s1 = 0.f, s2 = 0.f, s3 = 0.f;
        const int kb = wave * 128;
#pragma unroll 8
        for (int k = 0; k < 128; ++k) { const float w = W[(size_t)(kb + k) * 6144]; s0 += ca[kb + k] * w; s1 += ca[1024 + kb + k] * w; s2 += ca[2048 + kb + k] * w; s3 += ca[3072 + kb + k] * w; }
        red[(wave * 4 + 0) * 64 + lane] = s0; red[(wave * 4 + 1) * 64 + lane] = s1; red[(wave * 4 + 2) * 64 + lane] = s2; red[(wave * 4 + 3) * 64 + lane] = s3;
        __syncthreads();
        if (tid < 256) { const int b = tid >> 6, col = tid & 63; float s = a.ada_b[l * 6144 + n0 + col];
#pragma unroll
            for (int w = 0; w < 8; ++w) s += red[(w * 4 + b) * 64 + col];
            mod[((size_t)l * 4 + b) * 6144 + n0 + col] = s; }
        __syncthreads();
    }
}
__device__ __forceinline__ void rope_phase(const Args& a, int gtid, int ngt) {
    f32x2* rope = (f32x2*)(a.ws + WS_ROPE);
    for (int i = gtid; i < T * 16; i += ngt) {
        const int t = i >> 4, k = i & 15;
        const double inv = exp(-(double)k * (9.210340371976184 / 16.0));
        const double ang = (double)a.pos[t] * inv;
        const double n = rint(ang * 0.15915494309189535);
        double r = fma(-n, 6.283185307179586, ang); r = fma(-n, 2.4492935982947064e-16, r);
        rope[i] = (f32x2){(float)cos(r), (float)sin(r)};
    }
}
__device__ __forceinline__ void norm_row(const float* xrow, bf16_t* orow, const float* g, const float* sc, const float* sh, int lane, f32x4 (&hv)[4]) {
    const f32x4* xr = (const f32x4*)xrow + lane;
    f32x4 v[4]; float s = 0.f;
#pragma unroll
    for (int j = 0; j < 4; ++j) { v[j] = xr[64 * j]; s += (v[j].x * v[j].x + v[j].y * v[j].y) + (v[j].z * v[j].z + v[j].w * v[j].w); }
    const float rstd = __builtin_amdgcn_rsqf(wave_sum(s) * (1.f / 1024.f) + EPS);
    u32x2* o8 = (u32x2*)orow + lane;
#pragma unroll
    for (int j = 0; j < 4; ++j) {
        const f32x4 gg = ((const f32x4*)g)[lane + 64 * j], cc = ((const f32x4*)sc)[lane + 64 * j], hh = ((const f32x4*)sh)[lane + 64 * j];
        f32x4 h = v[j] * rstd * gg * (cc + 1.f) + hh; hv[j] = h;
        u32x2 w; w.x = cvt_pk_bf16(h.x, h.y); w.y = cvt_pk_bf16(h.z, h.w); o8[64 * j] = w;
    }
}

__device__ __forceinline__ float tr_reduce16(const float (&a)[16], int lane) {
    float v[8];
    const bool b5 = (lane & 32) != 0;
#pragma unroll
    for (int i = 0; i < 8; ++i) { const float own = b5 ? a[i + 8] : a[i], snd = b5 ? a[i] : a[i + 8]; v[i] = own + __shfl_xor(snd, 32); }
    const bool b4 = (lane & 16) != 0;
#pragma unroll
    for (int i = 0; i < 4; ++i) { const float own = b4 ? v[i + 4] : v[i], snd = b4 ? v[i] : v[i + 4]; v[i] = own + __shfl_xor(snd, 16); }
    const bool b3 = (lane & 8) != 0;
#pragma unroll
    for (int i = 0; i < 2; ++i) { const float own = b3 ? v[i + 2] : v[i], snd = b3 ? v[i] : v[i + 2]; v[i] = own + __shfl_xor(snd, 8); }
    const bool b2 = (lane & 4) != 0;
    float r; { const float own = b2 ? v[1] : v[0], snd = b2 ? v[0] : v[1]; r = own + __shfl_xor(snd, 4); }
    r += __shfl_xor(r, 2); r += __shfl_xor(r, 1);
    return r;
}
constexpr int H1_BF = 0, H1_QT = 33792, H1_KT = H1_QT + 17408, H1_VT = H1_KT + 17408, H1_KD = H1_VT + 18432, H1_AT = H1_KD + 18432, H1_SEG = H1_AT + 9216, H1_END = H1_SEG + 2048;
static_assert(H1_END <= LDS_SCR_BYTES, "H1 LDS");
__device__ __forceinline__ void h1_unit(int u, bf16_t* QH, const bf16_t* LF, bf16_t* VH, bf16_t* UT, float* AC, LAS unsigned char* lds, int tid, int wave, int lane, bool dry = false) {
    LAS float* Bf = (LAS float*)(lds + H1_BF);
    LAS bf16_t* Qt = (LAS bf16_t*)(lds + H1_QT);
    LAS bf16_t* Kt = (LAS bf16_t*)(lds + H1_KT);
    LAS bf16_t* VT = (LAS bf16_t*)(lds + H1_VT);
    LAS bf16_t* KdT = (LAS bf16_t*)(lds + H1_KD);
    LAS bf16_t* At = (LAS bf16_t*)(lds + H1_AT);
    LAS float* seg = (LAS float*)(lds + H1_SEG);
    const int bh = u >> 6, c = u & 63, b = bh >> 2, h = bh & 3;
    const size_t rowbase = (size_t)b * SEQ + (size_t)c * 64; const int col0 = h * 128;
    u32x4 qv[2], lv[2], vv[2];
#pragma unroll
    for (int i = 0; i < 2; ++i) { const int ch = wave + 8 * i; const size_t o = (rowbase + lane) * 512 + col0 + ch * 8;
        qv[i] = *(const u32x4*)(QH + o); lv[i] = *(const u32x4*)(LF + o); vv[i] = *(const u32x4*)(VH + o); }
#pragma unroll
    for (int i = 0; i < 2; ++i) { const int ch = wave + 8 * i; f32x4 a0, a1; unpack8(lv[i], a0, a1);
        *(LAS f32x4*)(Bf + lane * 132 + ch * 8) = a0; *(LAS f32x4*)(Bf + lane * 132 + ch * 8 + 4) = a1; }
    __syncthreads();
    { const int d = tid & 127, sg = tid >> 7; float run = 0.f;
#pragma unroll
        for (int r = 0; r < 16; ++r) { run += Bf[(sg * 16 + r) * 132 + d]; Bf[(sg * 16 + r) * 132 + d] = run; }
        seg[sg * 128 + d] = run;
        __syncthreads();
        float off = 0.f;
#pragma unroll
        for (int s = 0; s < 3; ++s) off += (s < sg) ? seg[s * 128 + d] : 0.f;
        if (sg > 0) {
#pragma unroll
            for (int r = 0; r < 16; ++r) Bf[(sg * 16 + r) * 132 + d] += off;
        }
    }
    __syncthreads();
#pragma unroll
    for (int i = 0; i < 2; ++i) {
        const int ch = wave + 8 * i, s = lane;
        f32x4 q0, q1, l0, l1, bb0, bb1, bl0, bl1, bm0, bm1;
        unpack8(qv[i], q0, q1); unpack8(lv[i], l0, l1);
        bb0 = *(const LAS f32x4*)(Bf + s * 132 + ch * 8); bb1 = *(const LAS f32x4*)(Bf + s * 132 + ch * 8 + 4);
        bl0 = *(const LAS f32x4*)(Bf + 63 * 132 + ch * 8); bl1 = *(const LAS f32x4*)(Bf + 63 * 132 + ch * 8 + 4);
        bm0 = *(const LAS f32x4*)(Bf + 31 * 132 + ch * 8); bm1 = *(const LAS f32x4*)(Bf + 31 * 132 + ch * 8 + 4);
        f32x4 qt0, qt1, kt0, kt1, kd0, kd1, qh0, qh1;
#pragma unroll
        for (int j = 0; j < 4; ++j) {
            const float k0 = 1.f - fexp(l0[j]), k1 = 1.f - fexp(l1[j]);
            qt0[j] = q0[j] * fexp(bb0[j] - bm0[j]); qt1[j] = q1[j] * fexp(bb1[j] - bm1[j]);
            kt0[j] = k0 * fexp(bm0[j] - bb0[j]); kt1[j] = k1 * fexp(bm1[j] - bb1[j]);
            kd0[j] = k0 * fexp(bl0[j] - bb0[j]); kd1[j] = k1 * fexp(bl1[j] - bb1[j]);
            qh0[j] = q0[j] * fexp(bb0[j]); qh1[j] = q1[j] * fexp(bb1[j]);
        }
        *(LAS u32x4*)(Qt + s * 136 + ch * 8) = pack8(qt0, qt1);
        *(LAS u32x4*)(Kt + s * 136 + ch * 8) = pack8(kt0, kt1);
        const u32x4 kdp = pack8(kd0, kd1);
#pragma unroll
        for (int j = 0; j < 4; ++j) {
            const unsigned kx = (unsigned)__shfl_xor((int)kdp[j], 1), vx = (unsigned)__shfl_xor((int)vv[i][j], 1);
            const bool odd = (s & 1) != 0; const int se = s & ~1;
            const unsigned kw = odd ? ((kx >> 16) | (kdp[j] & 0xffff0000u)) : ((kdp[j] & 0xffffu) | (kx << 16));
            const unsigned vw = odd ? ((vx >> 16) | (vv[i][j] & 0xffff0000u)) : ((vv[i][j] & 0xffffu) | (vx << 16));
            *(LAS unsigned*)(KdT + (ch * 8 + 2 * j + (odd ? 1 : 0)) * 72 + se) = kw;
            *(LAS unsigned*)(VT + (ch * 8 + 2 * j + (odd ? 1 : 0)) * 72 + se) = vw;
        }
        if (!dry) *(u32x4*)(QH + (rowbase + s) * 512 + col0 + ch * 8) = pack8(qh0, qh1);
        if (s == 63 && !dry) { float* ac = AC + (size_t)u * 128 + ch * 8;
#pragma unroll
            for (int j = 0; j < 4; ++j) { ac[j] = fexp(bl0[j]); ac[4 + j] = fexp(bl1[j]); } }
    }
    __syncthreads();
    const int l15 = lane & 15, lq = lane >> 4;
    { const int tr = wave >> 1;
#pragma unroll
        for (int tci = 0; tci < 2; ++tci) { const int tc = (wave & 1) * 2 + tci; f32x4 acc = {0.f, 0.f, 0.f, 0.f};
            if (tc <= tr) {
#pragma unroll
                for (int ks = 0; ks < 4; ++ks) { const bf16x8 af = *(const LAS bf16x8*)(Qt + (16 * tr + l15) * 136 + 32 * ks + 8 * lq), bf = *(const LAS bf16x8*)(Kt + (16 * tc + l15) * 136 + 32 * ks + 8 * lq);
                    acc = __builtin_amdgcn_mfma_f32_16x16x32_bf16(af, bf, acc, 0, 0, 0); }
            }
#pragma unroll
            for (int r = 0; r < 4; ++r) { const int t = 16 * tr + 4 * lq + r, s = 16 * tc + l15; const float v = (s <= t) ? acc[r] : 0.f; const float vn = __shfl_xor(v, 1);
                if ((l15 & 1) == 0) *(LAS unsigned*)(At + t * 72 + s) = cvt_pk_bf16(v, vn); } }
    }
    __syncthreads();
    { const int vt = wave;
        bf16x8 af[2];
#pragma unroll
        for (int ks = 0; ks < 2; ++ks) af[ks] = *(const LAS bf16x8*)(VT + (16 * vt + l15) * 72 + 32 * ks + 8 * lq);
#pragma unroll
        for (int tt = 0; tt < 4; ++tt) { f32x4 acc = {0.f, 0.f, 0.f, 0.f};
#pragma unroll
            for (int ks = 0; ks < 2; ++ks) { const bf16x8 bf = *(const LAS bf16x8*)(At + (16 * tt + l15) * 72 + 32 * ks + 8 * lq); acc = __builtin_amdgcn_mfma_f32_16x16x32_bf16(af[ks], bf, acc, 0, 0, 0); }
            u32x2 w; w.x = cvt_pk_bf16(acc[0], acc[1]); w.y = cvt_pk_bf16(acc[2], acc[3]);
            if (!dry) *(u32x2*)(VH + (rowbase + 16 * tt + l15) * 512 + col0 + 16 * vt + 4 * lq) = w; }
    }
    { const int dt = wave;
        bf16x8 af[2];
#pragma unroll
        for (int ks = 0; ks < 2; ++ks) af[ks] = *(const LAS bf16x8*)(KdT + (16 * dt + l15) * 72 + 32 * ks + 8 * lq);
#pragma unroll
        for (int vt = 0; vt < 8; ++vt) { f32x4 acc = {0.f, 0.f, 0.f, 0.f};
#pragma unroll
            for (int ks = 0; ks < 2; ++ks) { const bf16x8 bf = *(const LAS bf16x8*)(VT + (16 * vt + l15) * 72 + 32 * ks + 8 * lq); acc = __builtin_amdgcn_mfma_f32_16x16x32_bf16(af[ks], bf, acc, 0, 0, 0); }
            u32x2 w; w.x = cvt_pk_bf16(acc[0], acc[1]); w.y = cvt_pk_bf16(acc[2], acc[3]);
            if (!dry) *(u32x2*)(UT + ((size_t)u * 128 + 16 * vt + l15) * 128 + 16 * dt + 4 * lq) = w; }
    }
    __syncthreads();
}

#ifndef SCAN_DPP
#define SCAN_DPP 1
#endif
__device__ __forceinline__ float wave_incl_scan(float x, int lane) {
#if SCAN_DPP
    x += __int_as_float(__builtin_amdgcn_update_dpp(0, __float_as_int(x), 0x111, 0xF, 0xF, true));
    x += __int_as_float(__builtin_amdgcn_update_dpp(0, __float_as_int(x), 0x112, 0xF, 0xF, true));
    x += __int_as_float(__builtin_amdgcn_update_dpp(0, __float_as_int(x), 0x114, 0xF, 0xF, true));
    x += __int_as_float(__builtin_amdgcn_update_dpp(0, __float_as_int(x), 0x118, 0xF, 0xF, true));
    const float t0 = __int_as_float(__builtin_amdgcn_readlane(__float_as_int(x), 15)), t1 = __int_as_float(__builtin_amdgcn_readlane(__float_as_int(x), 31)),
                t2 = __int_as_float(__builtin_amdgcn_readlane(__float_as_int(x), 47));
    const int row = lane >> 4;
    x += (row >= 1 ? t0 : 0.f) + (row >= 2 ? t1 : 0.f) + (row >= 3 ? t2 : 0.f);
#else
#pragma unroll
    for (int o = 1; o < 64; o <<= 1) { const float t = __shfl_up(x, o); if (lane >= o) x += t; }
#endif
    return x;
}
constexpr int H1B_HALF = 49152, H1B_QT = 0, H1B_KT = 17408, H1B_VT = 0, H1B_KD = 18432, H1B_AT = 36864;
static_assert(2 * H1B_HALF <= LDS_SCR_BYTES && H1B_AT + 9216 <= H1B_HALF, "H1 pair LDS");
__device__ __forceinline__ void h1_pair(int up, bf16_t* QH, const bf16_t* LF, bf16_t* VH, bf16_t* UT, float* AC, LAS unsigned char* lds, int tid, int wave, int lane) {
    const int hw = wave >> 2, w4 = wave & 3;
    LAS unsigned char* L = lds + hw * H1B_HALF;
    LAS bf16_t* Qt = (LAS bf16_t*)(L + H1B_QT);
    LAS bf16_t* Kt = (LAS bf16_t*)(L + H1B_KT);
    LAS bf16_t* VT = (LAS bf16_t*)(L + H1B_VT);
    LAS bf16_t* KdT = (LAS bf16_t*)(L + H1B_KD);
    LAS bf16_t* At = (LAS bf16_t*)(L + H1B_AT);
    const int u = up * 2 + hw;
    const int bh = u >> 6, c = u & 63, b = bh >> 2, h = bh & 3;
    const size_t rowbase = (size_t)b * SEQ + (size_t)c * 64; const int col0 = h * 128;
    const int s = lane;
    u32x4 qv[4], lv[4], vv[4], kdp[4];
#pragma unroll
    for (int i = 0; i < 4; ++i) { const int ch = w4 + 4 * i; const size_t o = (rowbase + s) * 512 + col0 + ch * 8;
        qv[i] = *(const u32x4*)(QH + o); lv[i] = *(const u32x4*)(LF + o); vv[i] = *(const u32x4*)(VH + o); }
#pragma unroll
    for (int i = 0; i < 4; ++i) {
        const int ch = w4 + 4 * i;
        f32x4 l0, l1, q0, q1; unpack8(lv[i], l0, l1); unpack8(qv[i], q0, q1);
        f32x4 qt0, qt1, kt0, kt1, kd0, kd1, qh0, qh1, ea0, ea1;
#pragma unroll
        for (int j = 0; j < 4; ++j) {
            const float bb0 = wave_incl_scan(l0[j], lane), bb1 = wave_incl_scan(l1[j], lane);
            const float bl0 = __int_as_float(__builtin_amdgcn_readlane(__float_as_int(bb0), 63)), bl1 = __int_as_float(__builtin_amdgcn_readlane(__float_as_int(bb1), 63));
            const float bm0 = __int_as_float(__builtin_amdgcn_readlane(__float_as_int(bb0), 31)), bm1 = __int_as_float(__builtin_amdgcn_readlane(__float_as_int(bb1), 31));
            const float k0 = 1.f - fexp(l0[j]), k1 = 1.f - fexp(l1[j]);
            qt0[j] = q0[j] * fexp(bb0 - bm0); qt1[j] = q1[j] * fexp(bb1 - bm1);
            kt0[j] = k0 * fexp(bm0 - bb0); kt1[j] = k1 * fexp(bm1 - bb1);
            kd0[j] = k0 * fexp(bl0 - bb0); kd1[j] = k1 * fexp(bl1 - bb1);
            ea0[j] = fexp(bb0); ea1[j] = fexp(bb1);
            qh0[j] = q0[j] * ea0[j]; qh1[j] = q1[j] * ea1[j];
        }
        *(LAS u32x4*)(Qt + s * 136 + ch * 8) = pack8(qt0, qt1);
        *(LAS u32x4*)(Kt + s * 136 + ch * 8) = pack8(kt0, kt1);
        kdp[i] = pack8(kd0, kd1);
        *(u32x4*)(QH + (rowbase + s) * 512 + col0 + ch * 8) = pack8(qh0, qh1);
        if (s == 63) { float* ac = AC + (size_t)u * 128 + ch * 8; *(f32x4*)ac = ea0; *(f32x4*)(ac + 4) = ea1; }
    }
    __syncthreads();
    const int l15 = lane & 15, lq = lane >> 4;
    { const int tr = w4;
#pragma unroll
        for (int tc = 0; tc < 4; ++tc) { f32x4 acc = {0.f, 0.f, 0.f, 0.f};
            if (tc <= tr) {
#pragma unroll
                for (int ks = 0; ks < 4; ++ks) { const bf16x8 af = *(const LAS bf16x8*)(Qt + (16 * tr + l15) * 136 + 32 * ks + 8 * lq), bf = *(const LAS bf16x8*)(Kt + (16 * tc + l15) * 136 + 32 * ks + 8 * lq);
                    acc = __builtin_amdgcn_mfma_f32_16x16x32_bf16(af, bf, acc, 0, 0, 0); }
            }
#pragma unroll
            for (int r = 0; r < 4; ++r) { const int t = 16 * tr + 4 * lq + r, ss = 16 * tc + l15; const float v = (ss <= t) ? acc[r] : 0.f; const float vn = __shfl_xor(v, 1);
                if ((l15 & 1) == 0) *(LAS unsigned*)(At + t * 72 + ss) = cvt_pk_bf16(v, vn); } }
    }
    __syncthreads();
#pragma unroll
    for (int i = 0; i < 4; ++i) { const int ch = w4 + 4 * i;
#pragma unroll
        for (int j = 0; j < 4; ++j) {
            const unsigned kx = (unsigned)__shfl_xor((int)kdp[i][j], 1), vx = (unsigned)__shfl_xor((int)vv[i][j], 1);
            const bool odd = (s & 1) != 0; const int se = s & ~1;
            const unsigned kw = odd ? ((kx >> 16) | (kdp[i][j] & 0xffff0000u)) : ((kdp[i][j] & 0xffffu) | (kx << 16));
            const unsigned vw = odd ? ((vx >> 16) | (vv[i][j] & 0xffff0000u)) : ((vv[i][j] & 0xffffu) | (vx << 16));
            *(LAS unsigned*)(KdT + (ch * 8 + 2 * j + (odd ? 1 : 0)) * 72 + se) = kw;
            *(LAS unsigned*)(VT + (ch * 8 + 2 * j + (odd ? 1 : 0)) * 72 + se) = vw;
        } }
    __syncthreads();
#pragma unroll
    for (int vi = 0; vi < 2; ++vi) { const int vt = 2 * w4 + vi;
        bf16x8 af[2];
#pragma unroll
        for (int ks = 0; ks < 2; ++ks) af[ks] = *(const LAS bf16x8*)(VT + (16 * vt + l15) * 72 + 32 * ks + 8 * lq);
#pragma unroll
        for (int tt = 0; tt < 4; ++tt) { f32x4 acc = {0.f, 0.f, 0.f, 0.f};
#pragma unroll
            for (int ks = 0; ks < 2; ++ks) { const bf16x8 bf = *(const LAS bf16x8*)(At + (16 * tt + l15) * 72 + 32 * ks + 8 * lq); acc = __builtin_amdgcn_mfma_f32_16x16x32_bf16(af[ks], bf, acc, 0, 0, 0); }
            u32x2 w; w.x = cvt_pk_bf16(acc[0], acc[1]); w.y = cvt_pk_bf16(acc[2], acc[3]);
            *(u32x2*)(VH + (rowbase + 16 * tt + l15) * 512 + col0 + 16 * vt + 4 * lq) = w; }
    }
#pragma unroll
    for (int di = 0; di < 2; ++di) { const int dt = 2 * w4 + di;
        bf16x8 af[2];
#pragma unroll
        for (int ks = 0; ks < 2; ++ks) af[ks] = *(const LAS bf16x8*)(KdT + (16 * dt + l15) * 72 + 32 * ks + 8 * lq);
#pragma unroll
        for (int vt = 0; vt < 8; ++vt) { f32x4 acc = {0.f, 0.f, 0.f, 0.f};
#pragma unroll
            for (int ks = 0; ks < 2; ++ks) { const bf16x8 bf = *(const LAS bf16x8*)(VT + (16 * vt + l15) * 72 + 32 * ks + 8 * lq); acc = __builtin_amdgcn_mfma_f32_16x16x32_bf16(af[ks], bf, acc, 0, 0, 0); }
            u32x2 w; w.x = cvt_pk_bf16(acc[0], acc[1]); w.y = cvt_pk_bf16(acc[2], acc[3]);
            *(u32x2*)(UT + ((size_t)u * 128 + 16 * vt + l15) * 128 + 16 * dt + 4 * lq) = w; }
    }
    __syncthreads();
}
__device__ __forceinline__ void h2_scan(bf16_t* UT, const float* AC, int tid, bool dry = false) {
    if (tid >= 256) return;
    for (int w = blockIdx.x * 256 + tid; w < 16 * 128 * 32; w += gridDim.x * 256) {
        const int bh = w >> 12, rem = w & 4095, v = rem >> 5, dq = rem & 31;
        bf16_t* p = UT + ((size_t)bh * 64 * 128 + v) * 128 + 4 * dq;
        const float* ap = AC + (size_t)bh * 64 * 128 + 4 * dq;
        f32x4 S = {0.f, 0.f, 0.f, 0.f};
        for (int c0 = 0; c0 < 64; c0 += 8) {
            u32x2 uu[8]; f32x4 aa[8];
#pragma unroll
            for (int k = 0; k < 8; ++k) { uu[k] = *(const u32x2*)(p + (size_t)(c0 + k) * 16384); aa[k] = *(const f32x4*)(ap + (size_t)(c0 + k) * 128); }
#pragma unroll
            for (int k = 0; k < 8; ++k) {
                u32x2 w2; w2.x = cvt_pk_bf16(S.x, S.y); w2.y = cvt_pk_bf16(S.z, S.w);
                if (!dry) *(u32x2*)(p + (size_t)(c0 + k) * 16384) = w2;
                const f32x4 uf = {bflo(uu[k].x), bfhi(uu[k].x), bflo(uu[k].y), bfhi(uu[k].y)};
                S = aa[k] * S + uf;
            }
        }
    }
}
__device__ __forceinline__ void h3_tile(int u, int tt, const bf16_t* QH, const bf16_t* VH, const bf16_t* HG, const bf16_t* UT, const float* gn, bf16_t* OA, int lane) {
    const int bh = u >> 6, c = u & 63, b = bh >> 2, h = bh & 3;
    const size_t row = (size_t)b * SEQ + (size_t)c * 64 + 16 * tt + (lane & 15); const int col0 = h * 128;
    const int l15 = lane & 15, lq = lane >> 4;
    bf16x8 bq[4];
#pragma unroll
    for (int ks = 0; ks < 4; ++ks) bq[ks] = *(const bf16x8*)(QH + row * 512 + col0 + 32 * ks + 8 * lq);
    f32x4 acc[8];
#pragma unroll
    for (int vt = 0; vt < 8; ++vt) { acc[vt] = (f32x4){0.f, 0.f, 0.f, 0.f};
#pragma unroll
        for (int ks = 0; ks < 4; ++ks) { const bf16x8 af = *(const bf16x8*)(UT + ((size_t)u * 128 + 16 * vt + l15) * 128 + 32 * ks + 8 * lq);
            acc[vt] = __builtin_amdgcn_mfma_f32_16x16x32_bf16(af, bq[ks], acc[vt], 0, 0, 0); } }
    float ss = 0.f;
#pragma unroll
    for (int vt = 0; vt < 8; ++vt) { const u32x2 iw = *(const u32x2*)(VH + row * 512 + col0 + 16 * vt + 4 * lq);
        acc[vt].x += bflo(iw.x); acc[vt].y += bfhi(iw.x); acc[vt].z += bflo(iw.y); acc[vt].w += bfhi(iw.y);
        ss += (acc[vt].x * acc[vt].x + acc[vt].y * acc[vt].y) + (acc[vt].z * acc[vt].z + acc[vt].w * acc[vt].w); }
    ss += __shfl_xor(ss, 16); ss += __shfl_xor(ss, 32);
    const float rstd = __builtin_amdgcn_rsqf(ss * (1.f / 128.f) + EPS);
#pragma unroll
    for (int vt = 0; vt < 8; ++vt) { const int cc = col0 + 16 * vt + 4 * lq;
        const f32x4 g = *(const f32x4*)(gn + cc); const u32x2 gw = *(const u32x2*)(HG + row * 512 + cc);
        const f32x4 o = acc[vt] * rstd * g * (f32x4){bflo(gw.x), bfhi(gw.x), bflo(gw.y), bfhi(gw.y)};
        u32x2 w; w.x = cvt_pk_bf16(o.x, o.y); w.y = cvt_pk_bf16(o.z, o.w);
        *(u32x2*)(OA + row * 512 + cc) = w; }
}

__device__ __forceinline__ Args load_args() {
#if defined(__HIP_DEVICE_COMPILE__)
    const __attribute__((address_space(4))) Args* ap = (const __attribute__((address_space(4))) Args*)__builtin_amdgcn_kernarg_segment_ptr();
    asm volatile("" : "+s"(ap));
    return *ap;
#else
    return Args{};
#endif
}
#define FRESH() int tid = tid0; asm volatile("" : "+v"(tid)); \
    const Args a = load_args(); \
    unsigned char* ws = a.ws; float* xo = a.out; \
    const int lane = tid & 63; const int wave = __builtin_amdgcn_readfirstlane(tid >> 6); const int gw = bx * NWAVES + wave; (void)lane; (void)wave; (void)gw; (void)xo
#define WSP(Tp, off) ((Tp*)(ws + (off)))
__global__ void __launch_bounds__(NTHR, 2) fwd(Args kargs) {
    extern __shared__ __attribute__((aligned(16))) unsigned char lds_raw[];
    LAS unsigned char* lds = (LAS unsigned char*)lds_raw;
    const int tid0 = threadIdx.x;
    const int G = gridDim.x, bx = blockIdx.x;
    const int NGW = G * NWAVES;
    unsigned* ctl = (unsigned*)(kargs.ws + WS_CTL);
    volatile LAS unsigned* MISC = (volatile LAS unsigned*)(lds + LDS_MISC);
    LAS int* UL = (LAS int*)(lds + LDS_MISC + 64);
    LAS int* NUN = (LAS int*)(lds + LDS_MISC + 512);
    LAS int* TCUM = (LAS int*)(lds + LDS_MISC + 576);
    for (int i = tid0; i < 1024; i += NTHR) ((LAS unsigned*)(lds + LDS_MISC))[i] = 0u;
    __syncthreads();
    XcdBarrier bar; bar.bar = ctl + CW_BAR; bar.x = 0; bar.st = nullptr;
    if (!MK_PER_PHASE) bar = xcd_barrier_post(ctl + CW_BAR, MISC);
    const int lo = kargs.ph_lo, hi = kargs.ph_hi;
#define IN(k) (lo <= (k) && (k) < hi)
#define SEAM(k) do { if (IN(k) && IN((k) + 1)) { if (MK_PER_PHASE) { if (tid0 == 0) __hip_atomic_store(ctl + CW_BAR + XB_TMO, 0xBADu, __ATOMIC_RELAXED, __HIP_MEMORY_SCOPE_AGENT); } else xcd_barrier(bar); } } while (0)

    if (PHEN(0) && IN(0)) {
        FRESH();
        for (int rep = 0; rep < REPS(14); ++rep) { mod_phase(a, lds, tid, wave, lane);
        rope_phase(a, bx * NTHR + tid, G * NTHR); }
        if (bx == G - 1) { float* lbv = WSP(float, WS_LB); for (int j = tid; j < 512; j += NTHR) { lbv[j] = 0.f; lbv[512 + j] = fsigmoid(a.lb_logits[512 + j] - a.lb_logits[j]); } }
        for (int rep = 0; rep < REPS(0); ++rep) conv_weights(a, 0, lds, gw, NGW, wave, lane);
    }
    SEAM(0);
    if (PHEN(1) && IN(1)) for (int rep = 0; rep < REPS(1); ++rep) {
        FRESH();
        const float* mod = WSP(float, WS_MOD); bf16_t* HN = WSP(bf16_t, WS_HN);
        for (int m = gw; m < T; m += NGW) { const float* mb = mod + (size_t)(m >> 12) * 6144; f32x4 hv[4];
            norm_row(a.x + (size_t)m * 1024, HN + (size_t)m * 1024, a.norm1_g, mb + 1024, mb, lane, hv); }
    }
    SEAM(1);
    int ph = 2;
    for (int l = 0; l < DEPTH; ++l) {
        if (PHEN(2) && IN(ph)) for (int rep = 0; rep < REPS(2); ++rep) {
            FRESH();
            pg8::ProbDense P; P.A = (const char*)WSP(bf16_t, WS_HN); P.Bt = (const char*)WSP(bf16_t, WS_WT + WT_IN); P.lda = 1024; P.ldb = 1024; P.K = 1024; P.S.init(T, NPROJ, G, bx);
            pg8::EpiProj E{WSP(bf16_t, WS_P + P_QH), WSP(bf16_t, WS_P + P_LF), WSP(bf16_t, WS_P + P_VH), WSP(bf16_t, WS_P + P_HG), WSP(bf16_t, WS_P + P_GT), WSP(bf16_t, WS_P + P_CKV),
                           WSP(bf16_t, WS_P + P_CQ), WSP(bf16_t, WS_P + P_KPE), WSP(float, WS_SSQKV), WSP(float, WS_SSQQ), WSP(float, WS_LB) + l * 512, WSP(const f32x2, WS_ROPE)};
            pg8::gemm_phase(lds, P, E, tid);
        }
        SEAM(ph); ++ph;
        if (PHEN(3) && IN(ph)) {
            for (int rep = 0; rep < REPS(3); ++rep) {
            if (!DBG_NOUP) { FRESH(); pg8::ProbDense P; P.A = (const char*)WSP(bf16_t, WS_P + P_CQ); P.Bt = (const char*)WSP(bf16_t, WS_WT + WT_QU); P.lda = 512; P.ldb = 384; P.K = 384; P.S.init(T, 768, G, bx);
              pg8::EpiQup E{WSP(bf16_t, WS_Q), WSP(float, WS_SSQQ), WSP(const f32x2, WS_ROPE)}; pg8::gemm_phase(lds, P, E, tid); }
            if (!DBG_NOUP) { FRESH(); pg8::ProbDense P; P.A = (const char*)WSP(bf16_t, WS_P + P_CKV); P.Bt = (const char*)WSP(bf16_t, WS_WT + WT_KV); P.lda = 256; P.ldb = 256; P.K = 256; P.S.init(T, 1024, G, (bx + 192) % G);
              pg8::EpiKVup E{WSP(bf16_t, WS_KN), WSP(bf16_t, WS_V), WSP(float, WS_SSQKV)}; pg8::gemm_phase(lds, P, E, tid); }
            }
            __syncthreads();
            { FRESH();
              for (int up = bx; up < 512; up += G) h1_pair(up, WSP(bf16_t, WS_P + P_QH), WSP(bf16_t, WS_P + P_LF), WSP(bf16_t, WS_P + P_VH), WSP(bf16_t, WS_UT), WSP(float, WS_AC), lds, tid, wave, lane); }
        }
        SEAM(ph); ++ph;
        if (PHEN(4) && IN(ph)) for (int rep = 0; rep < REPS(4); ++rep) { FRESH(); h2_scan(WSP(bf16_t, WS_UT), WSP(float, WS_AC), tid, rep > 0 && hi < 100000); }
        SEAM(ph); ++ph;
        if (PHEN(5) && IN(ph)) {
            for (int rep = 0; rep < REPS(5); ++rep) { FRESH();
              for (int p = bx; p < 256; p += G) { const int bh = p >> 3, s = p & 7;
                att::attn_unit(bh >> 3, bh & 7, 15 - s, WSP(bf16_t, WS_Q), WSP(bf16_t, WS_KN), WSP(bf16_t, WS_P + P_KPE), WSP(bf16_t, WS_V), WSP(bf16_t, WS_AO), (LAS char*)lds, tid);
                att::attn_unit(bh >> 3, bh & 7, s, WSP(bf16_t, WS_Q), WSP(bf16_t, WS_KN), WSP(bf16_t, WS_P + P_KPE), WSP(bf16_t, WS_V), WSP(bf16_t, WS_AO), (LAS char*)lds, tid); } }
            for (int rep = 0; rep < REPS(13); ++rep) { FRESH();
              for (int w = gw; w < 4096; w += NGW) h3_tile(w >> 2, w & 3, WSP(bf16_t, WS_P + P_QH), WSP(bf16_t, WS_P + P_VH), WSP(bf16_t, WS_P + P_HG), WSP(bf16_t, WS_UT), a.hg_norm_g + l * 512, WSP(bf16_t, WS_OA), lane); }
        }
        SEAM(ph); ++ph;
        if (PHEN(6) && IN(ph)) for (int rep = 0; rep < REPS(6); ++rep) {
            FRESH(); pg8::ProbDenseSplit P; P.A = (const char*)WSP(bf16_t, WS_OA); P.A2 = (const char*)WSP(bf16_t, WS_AO); P.Bt = (const char*)WSP(bf16_t, WS_WT + WT_BA); P.lda = 512; P.ldb = 1024; P.K = 1024; P.ksplit = 8; P.S.init(T, 1024, G, bx);
            pg8::EpiBr E{WSP(bf16_t, WS_MG), WSP(bf16_t, WS_P + P_GT)}; pg8::gemm_phase(lds, P, E, tid);
        }
        SEAM(ph); ++ph;
        if (PHEN(7) && IN(ph)) for (int rep = 0; rep < REPS(7); ++rep) {
            FRESH();
            pg8::ProbDense P; P.A = (const char*)WSP(bf16_t, WS_MG); P.Bt = (const char*)WSP(bf16_t, WS_WT + WT_OUT); P.lda = 1024; P.ldb = 1024; P.K = 1024; P.S.init(T, 1024, G, bx);
            pg8::EpiOut E{(l == 0) ? a.x : (const float*)nullptr, (const bf16_t*)xo, WSP(bf16_t, WS_XB), WSP(float, WS_MOD) + (size_t)l * 4 * 6144 + 2048, (rep > 0 && hi < 100000) ? 1 : 0}; pg8::gemm_phase(lds, P, E, tid);
        }
        SEAM(ph); ++ph;
        if (PHEN(8) && IN(ph)) for (int rep = 0; rep < REPS(8); ++rep) {
            FRESH(); const bool dry = rep > 0 && hi < 100000;
            const float* modl = WSP(float, WS_MOD) + (size_t)l * 4 * 6144; bf16_t* HN = WSP(bf16_t, WS_HN);
            int* TL = WSP(int, WS_TL); float* WL = WSP(float, WS_WL); int* TS = WSP(int, WS_TS); const bf16_t* XB = WSP(bf16_t, WS_XB);
            LAS float* wrT = (LAS float*)lds;
            LAS int* lcnt = (LAS int*)(lds + 16 * 1028 * 4);
            LAS int* rec = lcnt + 64;
            LAS float* LG = (LAS float*)(rec + 64 * 8);
            for (int i = tid; i < 16384; i += NTHR) wrT[(i & 15) * 1028 + (i >> 4)] = a.w_router[i];
            if (tid < 32) lcnt[tid] = 0;
            __syncthreads();
            constexpr int RPW = 64, RQ = 4;
            const float* g2n = a.norm2_g + l * 1024;
#pragma unroll 1
            for (int grp = 0; grp < 8 / RQ; ++grp) {
                const int rl0 = wave * 8 + grp * RQ; const int m0 = bx * RPW + rl0;
                unsigned wro = (unsigned)(4 * lane) * 4u; asm volatile("" : "+v"(wro));
                const float* mb = modl + (size_t)(m0 >> 12) * 6144;
                f32x4 hv[RQ][4]; float ssq[RQ];
#pragma unroll
                for (int q = 0; q < RQ; ++q) { const u32x2* xr = (const u32x2*)(XB + (size_t)(m0 + q) * 1024) + lane; float s = 0.f;
#pragma unroll
                    for (int j = 0; j < 4; ++j) { const u32x2 xw = xr[64 * j]; hv[q][j] = (f32x4){bflo(xw.x), bfhi(xw.x), bflo(xw.y), bfhi(xw.y)}; s += (hv[q][j].x * hv[q][j].x + hv[q][j].y * hv[q][j].y) + (hv[q][j].z * hv[q][j].z + hv[q][j].w * hv[q][j].w); }
                    ssq[q] = s; }
#pragma unroll
                for (int o = 1; o < 64; o <<= 1) {
#pragma unroll
                    for (int q = 0; q < RQ; ++q) ssq[q] += __shfl_xor(ssq[q], o); }
#pragma unroll
                for (int j = 0; j < 4; ++j) {
                    const f32x4 gg = ((const f32x4*)g2n)[lane + 64 * j], cc = ((const f32x4*)(mb + 4 * 1024))[lane + 64 * j], hh = ((const f32x4*)(mb + 3 * 1024))[lane + 64 * j];
#pragma unroll
                    for (int q = 0; q < RQ; ++q) { const float rstd = __builtin_amdgcn_rsqf(ssq[q] * (1.f / 1024.f) + EPS);
                        const f32x4 h = hv[q][j] * rstd * gg * (cc + 1.f) + hh; hv[q][j] = h;
                        u32x2 w; w.x = cvt_pk_bf16(h.x, h.y); w.y = cvt_pk_bf16(h.z, h.w); ((u32x2*)(HN + (size_t)(m0 + q) * 1024))[lane + 64 * j] = w; }
                }
                float acc[RQ][16];
#pragma unroll
                for (int e = 0; e < 16; ++e) {
#pragma unroll
                    for (int q = 0; q < RQ; ++q) acc[q][e] = 0.f;
#pragma unroll
                    for (int j = 0; j < 4; ++j) { const f32x4 w = *(const LAS f32x4*)((const LAS char*)wrT + wro + (e * 1028 + 256 * j) * 4);
#pragma unroll
                        for (int q = 0; q < RQ; ++q) acc[q][e] += (hv[q][j].x * w.x + hv[q][j].y * w.y) + (hv[q][j].z * w.z + hv[q][j].w * w.w); }
#pragma unroll
                    for (int q = 0; q < RQ; ++q) asm volatile("" : "+v"(acc[q][e]));
                    __builtin_amdgcn_sched_barrier(0);
                }
#pragma unroll
                for (int q = 0; q < RQ; ++q) {
                    const float tot = tr_reduce16(acc[q], lane);
                    const int e = ((lane >> 5) & 1) * 8 + ((lane >> 4) & 1) * 4 + ((lane >> 3) & 1) * 2 + ((lane >> 2) & 1);
                    if ((lane & 3) == 0) LG[(rl0 + q) * 16 + e] = tot;
                }
            }
            __syncthreads();
            if (tid < RPW) {
                const int rl = tid;
                float sc[16], bz[16];
#pragma unroll
                for (int e4 = 0; e4 < 4; ++e4) { const f32x4 lg = *(const LAS f32x4*)(LG + rl * 16 + 4 * e4);
#pragma unroll
                    for (int k = 0; k < 4; ++k) { sc[4 * e4 + k] = fsigmoid(lg[k]); bz[4 * e4 + k] = sc[4 * e4 + k] + a.router_bias[4 * e4 + k]; } }
                float gs[4];
#pragma unroll
                for (int g = 0; g < 4; ++g) { const float p = bz[4 * g], q = bz[4 * g + 1], r = bz[4 * g + 2], s2 = bz[4 * g + 3];
                    const float h1 = fmaxf(p, q), l1 = fminf(p, q), h2 = fmaxf(r, s2), l2 = fminf(r, s2);
                    gs[g] = fmaxf(h1, h2) + fmaxf(fminf(h1, h2), fmaxf(l1, l2)); }
                int gi = 0; float gb = gs[0];
#pragma unroll
                for (int g = 1; g < 4; ++g) if (gs[g] > gb) { gb = gs[g]; gi = g; }
                float c0 = bz[0], c1 = bz[1], c2 = bz[2], c3 = bz[3], t0 = sc[0], t1 = sc[1], t2 = sc[2], t3 = sc[3];
#pragma unroll
                for (int g = 1; g < 4; ++g) if (gi == g) { c0 = bz[4 * g]; c1 = bz[4 * g + 1]; c2 = bz[4 * g + 2]; c3 = bz[4 * g + 3]; t0 = sc[4 * g]; t1 = sc[4 * g + 1]; t2 = sc[4 * g + 2]; t3 = sc[4 * g + 3]; }
                int i1 = 0; float b1 = c0, s1 = t0;
                if (c1 > b1) { b1 = c1; i1 = 1; s1 = t1; } if (c2 > b1) { b1 = c2; i1 = 2; s1 = t2; } if (c3 > b1) { b1 = c3; i1 = 3; s1 = t3; }
                int i2 = -1; float b2v = -INFINITY, s2 = 0.f;
                if (i1 != 0 && c0 > b2v) { b2v = c0; i2 = 0; s2 = t0; } if (i1 != 1 && c1 > b2v) { b2v = c1; i2 = 1; s2 = t1; }
                if (i1 != 2 && c2 > b2v) { b2v = c2; i2 = 2; s2 = t2; } if (i1 != 3 && c3 > b2v) { b2v = c3; i2 = 3; s2 = t3; }
                if (i2 < 0) { i2 = (i1 == 0) ? 1 : 0; s2 = (i1 == 0) ? t1 : t0; }
                const int e1 = 4 * gi + i1, e2 = 4 * gi + i2; const float inv = 1.f / (s1 + s2);
                const int p1 = atomicAdd((int*)(lcnt + e1), 1), p2 = atomicAdd((int*)(lcnt + e2), 1);
                LAS int* rc = rec + rl * 8; rc[0] = e1; rc[1] = e2; rc[2] = p1; rc[3] = p2; rc[4] = __float_as_int(s1 * inv); rc[5] = __float_as_int(s2 * inv);
            }
            __syncthreads();
            if (tid < 16 && !dry) lcnt[16 + tid] = (int)__hip_atomic_fetch_add(ctl + CW_CNT + (l * 16 + tid) * 64, (unsigned)lcnt[tid], __ATOMIC_RELAXED, __HIP_MEMORY_SCOPE_AGENT);
            __syncthreads();
            if (tid < RPW && !dry) { const LAS int* rc = rec + tid * 8; const int m = bx * RPW + tid; const int e1 = rc[0], e2 = rc[1]; const int p1 = lcnt[16 + e1] + rc[2], p2 = lcnt[16 + e2] + rc[3];
                TL[e1 * T + p1] = m; TL[e2 * T + p2] = m; WL[e1 * T + p1] = __int_as_float(rc[4]); WL[e2 * T + p2] = __int_as_float(rc[5]);
                TS[2 * m] = (e1 << 16) | p1; TS[2 * m + 1] = (e2 << 16) | p2; }
            __syncthreads();
        }
        SEAM(ph); ++ph;
#define MOE_SETUP() do { if (tid == 0) { int cum = 0; \
            _Pragma("unroll") for (int e = 0; e < 16; ++e) { const int cn = (int)__hip_atomic_load(ctl + CW_CNT + (l * 16 + e) * 64, __ATOMIC_RELAXED, __HIP_MEMORY_SCOPE_AGENT); TCUM[32 + e] = cn; TCUM[e] = cum; cum += (cn + 255) >> 8; } \
            TCUM[16] = cum; int n = 0; \
            for (int L = bx; L < cum * 4 && n < 8; L += G, ++n) { const int tile = L >> 2, pn = L & 3; int e = 0; \
                _Pragma("unroll") for (int k = 1; k < 16; ++k) if (tile >= TCUM[k]) e = k; \
                const int rt = tile - TCUM[e]; int nv = TCUM[32 + e] - rt * 256; nv = nv > 256 ? 256 : nv; \
                UL[n * 8 + 0] = tile; UL[n * 8 + 1] = pn; UL[n * 8 + 2] = e; UL[n * 8 + 3] = rt; UL[n * 8 + 4] = nv; } \
            NUN[0] = n; } \
        __syncthreads(); } while (0)
        if (PHEN(9) && IN(ph)) {
            FRESH();
            MOE_SETUP();
            const int nun = __builtin_amdgcn_readfirstlane(NUN[0]);
            pg8::ProbMoeGU P; P.A = (const char*)WSP(bf16_t, WS_HN); P.Bt = (const char*)WSP(bf16_t, WS_WT + WT_GU); P.TL = WSP(int, WS_TL); P.ul = UL; P.nun = nun; P.lda = 1024; P.ldb = 1024; P.K = 1024;
            pg8::EpiGU E{WSP(bf16_t, WS_HE)}; for (int rep = 0; rep < REPS(9); ++rep) pg8::gemm_phase(lds, P, E, tid);
            __syncthreads();
        }
        SEAM(ph); ++ph;
        if (PHEN(11) && IN(ph)) {
            FRESH();
            MOE_SETUP();
            const int nun = __builtin_amdgcn_readfirstlane(NUN[0]);
            pg8::ProbMoeDown P; P.A = (const char*)WSP(bf16_t, WS_HE); P.Bt = (const char*)WSP(bf16_t, WS_WT + WT_DN); P.ul = UL; P.nun = nun; P.lda = 512; P.ldb = 512; P.K = 512;
            pg8::EpiDown E{WSP(bf16_t, WS_Y), WSP(float, WS_WL)}; for (int rep = 0; rep < REPS(11); ++rep) pg8::gemm_phase(lds, P, E, tid);
            __syncthreads();
        }
        SEAM(ph); ++ph;
        if (PHEN(10) && IN(ph)) {
            FRESH();
            const float* mod = WSP(float, WS_MOD); const float* modl = mod + (size_t)l * 4 * 6144; bf16_t* HN = WSP(bf16_t, WS_HN); const bf16_t* Yb = WSP(bf16_t, WS_Y); const int* TS = WSP(int, WS_TS);
            if (tid == 0) { int cum = 0;
#pragma unroll
                for (int e = 0; e < 16; ++e) { const int cn = (int)__hip_atomic_load(ctl + CW_CNT + (l * 16 + e) * 64, __ATOMIC_RELAXED, __HIP_MEMORY_SCOPE_AGENT); TCUM[e] = cum; cum += (cn + 255) >> 8; } }
            __syncthreads();
            for (int rep = 0; rep < REPS(10); ++rep)
            for (int m = gw; m < T; m += NGW) { const bool dry = rep > 0 && hi < 100000;
                const float* mb = modl + (size_t)(m >> 12) * 6144;
                const int t1 = TS[2 * m], t2 = TS[2 * m + 1];
                const size_t r1 = (size_t)TCUM[t1 >> 16] * 256 + (t1 & 0xffff), r2 = (size_t)TCUM[t2 >> 16] * 256 + (t2 & 0xffff);
                float* xr = xo + (size_t)m * 1024;
                const u32x2* xbr = (const u32x2*)(WSP(bf16_t, WS_XB) + (size_t)m * 1024);
                u32x2* xar = (u32x2*)((bf16_t*)xo + (size_t)m * 1024);
                f32x4 v[4]; float s = 0.f;
#pragma unroll
                for (int j = 0; j < 4; ++j) {
                    const u32x2 xw = xbr[lane + 64 * j]; const f32x4 x0 = (f32x4){bflo(xw.x), bfhi(xw.x), bflo(xw.y), bfhi(xw.y)}; const f32x4 g2 = ((const f32x4*)(mb + 5 * 1024))[lane + 64 * j];
                    const u32x2 y1 = ((const u32x2*)(Yb + r1 * 1024))[lane + 64 * j], y2 = ((const u32x2*)(Yb + r2 * 1024))[lane + 64 * j];
                    const f32x4 ys = (f32x4){bflo(y1.x) + bflo(y2.x), bfhi(y1.x) + bfhi(y2.x), bflo(y1.y) + bflo(y2.y), bfhi(y1.y) + bfhi(y2.y)};
                    v[j] = x0 + g2 * ys;
                    s += (v[j].x * v[j].x + v[j].y * v[j].y) + (v[j].z * v[j].z + v[j].w * v[j].w);
                }
                const float rstd = __builtin_amdgcn_rsqf(wave_sum(s) * (1.f / 1024.f) + EPS);
                if (l + 1 < DEPTH) {
                    const float* mn = mod + ((size_t)(l + 1) * 4 + (m >> 12)) * 6144;
                    u32x2* o8 = (u32x2*)(HN + (size_t)m * 1024) + lane;
                    if (!dry)
#pragma unroll
                    for (int j = 0; j < 4; ++j) { u32x2 xw; xw.x = cvt_pk_bf16(v[j].x, v[j].y); xw.y = cvt_pk_bf16(v[j].z, v[j].w); xar[lane + 64 * j] = xw;
                        const f32x4 gg = ((const f32x4*)(a.norm1_g + (l + 1) * 1024))[lane + 64 * j], cc = ((const f32x4*)(mn + 1024))[lane + 64 * j], hh = ((const f32x4*)mn)[lane + 64 * j];
                        const f32x4 h = v[j] * rstd * gg * (cc + 1.f) + hh; u32x2 w; w.x = cvt_pk_bf16(h.x, h.y); w.y = cvt_pk_bf16(h.z, h.w); o8[64 * j] = w; }
                } else {
                    if (!dry)
#pragma unroll
                    for (int j = 0; j < 4; ++j) { const f32x4 gg = ((const f32x4*)a.final_g)[lane + 64 * j]; ((f32x4*)xr)[lane + 64 * j] = v[j] * rstd * gg; }
                }
            }
            if (l + 1 < DEPTH) { __syncthreads(); conv_weights(a, l + 1, lds, gw, NGW, wave, lane); }
        }
        if (l + 1 < DEPTH) SEAM(ph);
        ++ph;
    }
#undef IN
#undef SEAM
}
constexpr int N_PHASES = 2 + DEPTH * 10;


#ifndef DBG_NAN
#define DBG_NAN 0
#endif
#if DBG_NAN
struct DbgReg { size_t off; size_t n; int f32; };
__global__ void dbg_scan(unsigned char* ws, const float* out) {
    const DbgReg regs[] = {
        {WS_MOD, 2 * 4 * 6144, 1}, {WS_LB, 1024, 1}, {WS_ROPE, (size_t)T * 32, 1}, {WS_SSQKV, (size_t)T * 8, 1}, {WS_SSQQ, (size_t)T * 16, 1}, {WS_AC, 1024 * 128, 1},
        {WS_WT, WT_END / 2, 0}, {WS_HN, (size_t)T * 1024, 0}, {WS_P + P_QH, (size_t)T * 512, 0}, {WS_P + P_LF, (size_t)T * 512, 0}, {WS_P + P_VH, (size_t)T * 512, 0},
        {WS_P + P_HG, (size_t)T * 512, 0}, {WS_P + P_GT, (size_t)T * 2048, 0}, {WS_P + P_CKV, (size_t)T * 256, 0}, {WS_P + P_CQ, (size_t)T * 512, 0}, {WS_P + P_KPE, (size_t)T * 32, 0},
        {WS_Q, (size_t)T * 768, 0}, {WS_KN, (size_t)T * 512, 0}, {WS_V, (size_t)T * 512, 0}, {WS_UT, (size_t)1024 * 128 * 128, 0}};
    unsigned* flags = (unsigned*)(ws + WS_CTL) + 8192;
    const size_t gt = (size_t)blockIdx.x * blockDim.x + threadIdx.x, ng = (size_t)gridDim.x * blockDim.x;
    for (int r = 0; r < 20; ++r) {
        bool bad = false;
        if (regs[r].f32) { const unsigned* p = (const unsigned*)(ws + regs[r].off); for (size_t i = gt; i < regs[r].n; i += ng) bad |= (p[i] & 0x7F800000u) == 0x7F800000u; }
        else { const unsigned short* p = (const unsigned short*)(ws + regs[r].off); for (size_t i = gt; i < regs[r].n; i += ng) bad |= (p[i] & 0x7F80u) == 0x7F80u; }
        if (bad) atomicOr(flags, 1u << r);
    }
    { bool bad = false; const unsigned* p = (const unsigned*)out; for (size_t i = gt; i < (size_t)T * 1024; i += ng) bad |= (p[i] & 0x7F800000u) == 0x7F800000u; if (bad) atomicOr(flags, 1u << 20); }
}
#ifndef DBG_REG
#define DBG_REG 19
#endif
#ifndef DBG_MODE
#define DBG_MODE 0
#endif
__global__ void dbg_stat(unsigned char* ws, size_t off, size_t n, int f32) {
    unsigned* st = (unsigned*)(ws + WS_CTL) + 8200;
    const size_t gt = (size_t)blockIdx.x * blockDim.x + threadIdx.x, ng = (size_t)gridDim.x * blockDim.x;
    unsigned mx = 0, cnt = 0;
    for (size_t i = gt; i < n; i += ng) { unsigned u = f32 ? ((const unsigned*)(ws + off))[i] : ((unsigned)((const unsigned short*)(ws + off))[i] << 16);
        if ((u & 0x7F800000u) == 0x7F800000u) ++cnt; else { u &= 0x7FFFFFFFu; mx = u > mx ? u : mx; } }
    atomicMax(st, mx); if (cnt) atomicAdd(st + 1, cnt);
}
__global__ void dbg_write2(unsigned char* ws, float* out) {
    const unsigned* st = (const unsigned*)(ws + WS_CTL) + 8200;
    const size_t gt = (size_t)blockIdx.x * blockDim.x + threadIdx.x, ng = (size_t)gridDim.x * blockDim.x;
    for (size_t i = gt; i < (size_t)T * 1024; i += ng) out[i] = 0.f;
    if (gt == 0) out[0] = DBG_MODE == 0 ? 1e3f * __uint_as_float(st[0]) : 1e3f + (float)st[1];
}
__global__ void dbg_write(unsigned char* ws, float* out) {
    const unsigned flags = ((const unsigned*)(ws + WS_CTL))[8192];
    const size_t gt = (size_t)blockIdx.x * blockDim.x + threadIdx.x, ng = (size_t)gridDim.x * blockDim.x;
    for (size_t i = gt; i < (size_t)T * 1024; i += ng) out[i] = 0.f;
    if (gt == 0) { float v = 500.f; if (flags) { v = 1000.f; for (int k = 0; k < __builtin_ctz(flags); ++k) v *= 2.f; } out[0] = v; }
}
#endif
extern "C" void kernel_launch(void* const* d_in, const int* in_sizes, int n_in, void* d_out, int out_size, void* d_ws, size_t ws_size, hipStream_t stream) {
    static int ok = 0;
    if (ok == 0) {
        if (n_in != 23 || in_sizes[0] != T * DM || out_size != T * DM || ws_size < WS_END) {
            fprintf(stderr, "kernel_launch: unexpected shapes: n_in %d in0 %d out %d ws %zu (need %zu)\n", n_in, n_in > 0 ? in_sizes[0] : -1, out_size, ws_size, (size_t)WS_END); ok = -1; return; }
        if (hipFuncSetAttribute((const void*)fwd, hipFuncAttributeMaxDynamicSharedMemorySize, LDS_BYTES) != hipSuccess) { fprintf(stderr, "kernel_launch: hipFuncSetAttribute failed\n"); ok = -1; return; }
        int per_cu = 0;
        if (hipOccupancyMaxActiveBlocksPerMultiprocessor(&per_cu, (const void*)fwd, NTHR, LDS_BYTES) != hipSuccess || per_cu < 1)
            fprintf(stderr, "kernel_launch: note: occupancy query reports %d workgroups per CU\n", per_cu);
        (void)hipGetLastError();
        ok = 1;
    }
    if (ok < 0) return;
    (void)hipMemsetAsync((char*)d_ws + WS_CTL, 0, CTL_BYTES, stream);
    Args a{};
    a.x = (const float*)d_in[0]; a.c = (const float*)d_in[1]; a.pos = (const int*)d_in[2]; a.ada_w = (const float*)d_in[3]; a.ada_b = (const float*)d_in[4];
    a.norm1_g = (const float*)d_in[5]; a.w_in = (const float*)d_in[6]; a.lb_logits = (const float*)d_in[7]; a.hg_norm_g = (const float*)d_in[8]; a.q_norm_g = (const float*)d_in[9];
    a.w_q_up = (const float*)d_in[10]; a.kv_norm_g = (const float*)d_in[11]; a.w_kv_up = (const float*)d_in[12]; a.w_br_a = (const float*)d_in[13]; a.w_br_b = (const float*)d_in[14];
    a.w_out = (const float*)d_in[15]; a.norm2_g = (const float*)d_in[16]; a.w_router = (const float*)d_in[17]; a.router_bias = (const float*)d_in[18];
    a.w_gate = (const float*)d_in[19]; a.w_up = (const float*)d_in[20]; a.w_down = (const float*)d_in[21]; a.final_g = (const float*)d_in[22];
    a.out = (float*)d_out; a.ws = (unsigned char*)d_ws;
    const int grid = 256;
#if MK_PER_PHASE
#ifndef MAXPH
#define MAXPH N_PHASES
#endif
    for (int p = 0; p < MAXPH; ++p) { a.ph_lo = p; a.ph_hi = p + 1; hipLaunchKernelGGL(fwd, dim3(grid), dim3(NTHR), LDS_BYTES, stream, a); }
#else
    a.ph_lo = 0; a.ph_hi = N_PHASES; hipLaunchKernelGGL(fwd, dim3(grid), dim3(NTHR), LDS_BYTES, stream, a);
#endif
#if DBG_NAN
    if (DBG_REG < 0) {
    hipLaunchKernelGGL(dbg_scan, dim3(1024), dim3(256), 0, stream, (unsigned char*)d_ws, (const float*)d_out);
    hipLaunchKernelGGL(dbg_write, dim3(1024), dim3(256), 0, stream, (unsigned char*)d_ws, (float*)d_out);
    } else {
    const DbgReg regs[] = {
        {WS_MOD, 2 * 4 * 6144, 1}, {WS_LB, 1024, 1}, {WS_ROPE, (size_t)T * 32, 1}, {WS_SSQKV, (size_t)T * 8, 1}, {WS_SSQQ, (size_t)T * 16, 1}, {WS_AC, 1024 * 128, 1},
        {WS_WT, WT_END / 2, 0}, {WS_HN, (size_t)T * 1024, 0}, {WS_P + P_QH, (size_t)T * 512, 0}, {WS_P + P_LF, (size_t)T * 512, 0}, {WS_P + P_VH, (size_t)T * 512, 0},
        {WS_P + P_HG, (size_t)T * 512, 0}, {WS_P + P_GT, (size_t)T * 2048, 0}, {WS_P + P_CKV, (size_t)T * 256, 0}, {WS_P + P_CQ, (size_t)T * 512, 0}, {WS_P + P_KPE, (size_t)T * 32, 0},
        {WS_Q, (size_t)T * 768, 0}, {WS_KN, (size_t)T * 512, 0}, {WS_V, (size_t)T * 512, 0}, {WS_UT, (size_t)1024 * 128 * 128, 0}};
    const int r = DBG_REG < 0 ? 0 : DBG_REG;
    hipLaunchKernelGGL(dbg_stat, dim3(1024), dim3(256), 0, stream, (unsigned char*)d_ws, regs[r].off, regs[r].n, regs[r].f32);
    hipLaunchKernelGGL(dbg_write2, dim3(1024), dim3(256), 0, stream, (unsigned char*)d_ws, (float*)d_out);
    }
#endif
    const hipError_t le = hipPeekAtLastError();
    if (le != hipSuccess) fprintf(stderr, "kernel_launch: launch failed: %s\n", hipGetErrorName(le));
}
```
